# Optimizing an MI355X kernel written in HIP

```python
import math
import jax, jax.numpy as jnp
from jax import lax
import numpy as np

D_MODEL = 2048
BATCH = 4
SEQ = 2048
DEPTH = 2
DEC_BATCH = 128
DEC_SEQ = 4
PAST_LEN = 8192
PAGE_SIZE = 128

A_HEADS = 16
A_HEAD_DIM = 64
A_WIDTH = A_HEADS * A_HEAD_DIM
DECAY_LORA = 64
ICLR_LORA = 64
GATE_LORA = 160
A_PROJ = 3 * A_WIDTH + DECAY_LORA + ICLR_LORA + GATE_LORA
GN_EPS = 64e-5
Q_HEADS = 16
KV_HEADS = 4
GROUP = Q_HEADS // KV_HEADS
HEAD_DIM = 64
Q_W = Q_HEADS * HEAD_DIM
KV_W = KV_HEADS * HEAD_DIM
WINDOW = 128
ROPE_DIM = HEAD_DIM // 4
ROPE_THETA = 500000.0
B_PROJ = Q_W + 2 * KV_W
IN_PROJ = A_PROJ + B_PROJ
D_FF = 5632
N_MOD = 9
RMS_EPS = 1e-6

kernel_name = 'hybrid_rwkv7_swa_sink_macaron_adaln_step'


def rms_norm(x, gain):
    xf = x.astype(jnp.float32)
    y = xf * lax.rsqrt(jnp.mean(xf * xf, axis=-1, keepdims=True) + RMS_EPS)
    return (y * gain.astype(jnp.float32)).astype(x.dtype)


def ada_norm(x, gain, shift, scale):
    return rms_norm(x, gain) * (1 + scale) + shift


def swiglu(h, w_gate, w_up, w_down):
    return (jax.nn.silu(h @ w_gate) * (h @ w_up)) @ w_down


def rope_partial(x, pos):
    half = ROPE_DIM // 2
    inv = 1.0 / (ROPE_THETA ** (jnp.arange(0, ROPE_DIM, 2, dtype=jnp.float32) / ROPE_DIM))
    ang = pos.astype(jnp.float32)[:, None] * inv[None, :]
    cos = jnp.cos(ang)[:, None, :]
    sin = jnp.sin(ang)[:, None, :]
    xr = x[..., :ROPE_DIM].astype(jnp.float32)
    x1, x2 = xr[..., :half], xr[..., half:]
    rot = jnp.concatenate([x1 * cos - x2 * sin, x2 * cos + x1 * sin], axis=-1).astype(x.dtype)
    return jnp.concatenate([rot, x[..., ROPE_DIM:]], axis=-1)


def sink_attention(q, k, v, mask, sinks):
    s = jnp.einsum('...qkgd,...skd->...kgqs', q, k).astype(jnp.float32) * (HEAD_DIM ** -0.5)
    s = jnp.where(mask, s, -jnp.inf)
    sink = jnp.broadcast_to(sinks.astype(jnp.float32).reshape(KV_HEADS, GROUP, 1, 1), s.shape[:-1] + (1,))
    p = jax.nn.softmax(jnp.concatenate([s, sink], axis=-1), axis=-1)[..., :-1]
    return jnp.einsum('...kgqs,...skd->...qkgd', p.astype(v.dtype), v)


def swa_mixer(pb, pos, k_prev, v_prev, sinks):
    B, T, _ = pb.shape
    q = rope_partial(pb[..., :Q_W].reshape(B, T, Q_HEADS, HEAD_DIM), pos)
    k = rope_partial(pb[..., Q_W:Q_W + KV_W].reshape(B, T, KV_HEADS, HEAD_DIM), pos)
    v = pb[..., Q_W + KV_W:].reshape(B, T, KV_HEADS, HEAD_DIM)
    qg = q.reshape(B, T, KV_HEADS, GROUP, HEAD_DIM)
    if k_prev is None:
        nb = T // WINDOW
        qb = qg.reshape(B, nb, WINDOW, KV_HEADS, GROUP, HEAD_DIM)
        kb = k.reshape(B, nb, WINDOW, KV_HEADS, HEAD_DIM)
        vb = v.reshape(B, nb, WINDOW, KV_HEADS, HEAD_DIM)
        pad = jnp.zeros_like(kb[:, :1])
        kk = jnp.concatenate([jnp.concatenate([pad, kb[:, :-1]], axis=1), kb], axis=2)
        vv = jnp.concatenate([jnp.concatenate([pad, vb[:, :-1]], axis=1), vb], axis=2)
        i = jnp.arange(WINDOW)[:, None]
        j = jnp.arange(2 * WINDOW)[None, :]
        diff = WINDOW + i - j
        band = (diff >= 0) & (diff < WINDOW)
        first = (jnp.arange(nb) == 0)[:, None, None] & (j < WINDOW)[None]
        mask = (band[None] & ~first)[:, None, None]
        o = sink_attention(qb, kk, vv, mask, sinks).reshape(B, T, Q_W)
        new_k, new_v = k[:, -WINDOW:], v[:, -WINDOW:]
    else:
        kk = jnp.concatenate([k_prev.astype(k.dtype), k], axis=1)
        vv = jnp.concatenate([v_prev.astype(v.dtype), v], axis=1)
        kpos = jnp.concatenate([pos[0] - WINDOW + jnp.arange(WINDOW), pos])
        diff = pos[:, None] - kpos[None, :]
        mask = (diff >= 0) & (diff < WINDOW)
        o = sink_attention(qg, kk, vv, mask, sinks).reshape(B, T, Q_W)
        new_k, new_v = kk[:, -WINDOW:], vv[:, -WINDOW:]
    return o, new_k, new_v


def rwkv7_mixer(pa, shift_prev, wkv_prev, mu, w0, w2, a0, a2, g2, k_k, k_a, r_k, ln_w, ln_b):
    B, T, _ = pa.shape
    prev = jnp.concatenate([shift_prev[:, None].astype(pa.dtype), pa[:, :-1]], axis=1)
    xm = pa + (prev - pa) * mu
    r = xm[..., :A_WIDTH]
    k = xm[..., A_WIDTH:2 * A_WIDTH]
    v = xm[..., 2 * A_WIDTH:3 * A_WIDTH]
    o0 = 3 * A_WIDTH
    wd = xm[..., o0:o0 + DECAY_LORA]
    ad = xm[..., o0 + DECAY_LORA:o0 + DECAY_LORA + ICLR_LORA]
    gd = xm[..., o0 + DECAY_LORA + ICLR_LORA:]
    w_log = -jax.nn.softplus(-(w0 + jnp.tanh(wd) @ w2)) - 0.5
    a = jax.nn.sigmoid(a0 + ad @ a2)
    g = jax.nn.sigmoid(gd) @ g2
    heads = lambda t: t.reshape(B, T, A_HEADS, A_HEAD_DIM).astype(jnp.float32)
    kk = heads(k * k_k)
    kk = kk / jnp.maximum(jnp.sqrt(jnp.sum(kk * kk, axis=-1, keepdims=True)), 1e-12)
    k = k * (1 + (a - 1) * k_a)
    rh, kh, vh, ah = heads(r), heads(k), heads(v), heads(a)
    decay = jnp.exp(-jnp.exp(heads(w_log)))

    def step(S, inp):
        r_t, d_t, k_t, v_t, kk_t, a_t = inp
        sk = jnp.einsum('bhij,bhj->bhi', S, kk_t)
        S = S * d_t[:, :, None, :] - sk[..., :, None] * (kk_t * a_t)[:, :, None, :] + v_t[..., :, None] * k_t[:, :, None, :]
        return S, jnp.einsum('bhij,bhj->bhi', S, r_t)

    seq = tuple(jnp.swapaxes(t, 0, 1) for t in (rh, decay, kh, vh, kk, ah))
    S_T, o = lax.scan(step, wkv_prev.astype(jnp.float32), seq)
    o = jnp.swapaxes(o, 0, 1)
    mean = jnp.mean(o, axis=-1, keepdims=True)
    var = jnp.mean(jnp.square(o - mean), axis=-1, keepdims=True)
    o = (o - mean) * lax.rsqrt(var + GN_EPS)
    o = o * ln_w.astype(jnp.float32).reshape(A_HEADS, A_HEAD_DIM) + ln_b.astype(jnp.float32).reshape(A_HEADS, A_HEAD_DIM)
    bonus = jnp.sum(rh * kh * r_k.astype(jnp.float32), axis=-1, keepdims=True) * vh
    y = (o + bonus).reshape(B, T, A_WIDTH).astype(pa.dtype) * g
    return y, pa[:, -1], S_T


def decoder_layer(x, c, pos, shift_prev, wkv_prev, k_prev, v_prev,
                  norm_g, w_mod, b_mod, ffn_w_gate, ffn_w_up, ffn_w_down, w_in,
                  mu, w0, w2, a0, a2, g2, k_k, k_a, r_k, ln_w, ln_b, sinks,
                  w_branch_a, w_branch_b, w_merge_gate, w_out):
    mod = (jax.nn.silu(c) @ w_mod + b_mod).reshape(c.shape[0], N_MOD, 1, D_MODEL)
    h = ada_norm(x, norm_g[0], mod[:, 0], mod[:, 1])
    x = x + 0.5 * mod[:, 2] * swiglu(h, ffn_w_gate[0], ffn_w_up[0], ffn_w_down[0])
    h = ada_norm(x, norm_g[1], mod[:, 3], mod[:, 4])
    proj = h @ w_in
    ya, new_shift, new_wkv = rwkv7_mixer(proj[..., :A_PROJ], shift_prev, wkv_prev, mu, w0, w2, a0, a2, g2, k_k, k_a, r_k, ln_w, ln_b)
    yb, new_k, new_v = swa_mixer(proj[..., A_PROJ:], pos, k_prev, v_prev, sinks)
    gates = jax.nn.sigmoid(h @ w_merge_gate)
    merged = gates[..., :D_MODEL] * (ya @ w_branch_a) + gates[..., D_MODEL:] * (yb @ w_branch_b)
    x = x + mod[:, 5] * (merged @ w_out)
    h = ada_norm(x, norm_g[2], mod[:, 6], mod[:, 7])
    x = x + 0.5 * mod[:, 8] * swiglu(h, ffn_w_gate[1], ffn_w_up[1], ffn_w_down[1])
    return x, new_shift, new_wkv, new_k, new_v


def setup_inputs(seed: int = 0) -> dict:
    key = jax.random.key(seed)
    keys = iter(jax.random.split(key, 48))

    def nrm(shape, scale=1.0):
        return jax.random.normal(next(keys), shape, jnp.float32) * scale

    def uni(shape, lo, hi):
        return jax.random.uniform(next(keys), shape, jnp.float32, lo, hi)

    D, L = D_MODEL, DEPTH
    return {
        'x_prompt': nrm((BATCH, SEQ, D)),
        'x_sample': nrm((DEC_BATCH, DEC_SEQ, D)),
        'c_prompt': nrm((BATCH, D)),
        'c_sample': nrm((DEC_BATCH, D)),
        'state_shift': nrm((L, DEC_BATCH, A_PROJ)),
        'state_wkv': nrm((L, DEC_BATCH, A_HEADS, A_HEAD_DIM, A_HEAD_DIM)),
        'cache_k': nrm((L, DEC_BATCH, WINDOW, KV_HEADS, HEAD_DIM)),
        'cache_v': nrm((L, DEC_BATCH, WINDOW, KV_HEADS, HEAD_DIM)),
        'norm_g': 1.0 + nrm((L, 3, D), 0.02),
        'w_mod': nrm((L, D, N_MOD * D), 0.5 * D ** -0.5),
        'b_mod': nrm((L, N_MOD * D), 0.01),
        'ffn_w_gate': nrm((L, 2, D, D_FF), D ** -0.5),
        'ffn_w_up': nrm((L, 2, D, D_FF), D ** -0.5),
        'ffn_w_down': nrm((L, 2, D_FF, D), D_FF ** -0.5),
        'w_in': nrm((L, D, IN_PROJ), D ** -0.5),
        'rwkv_mu': uni((L, A_PROJ), 0.0, 1.0),
        'rwkv_w0': uni((L, A_WIDTH), -6.0, -1.0),
        'rwkv_w2': nrm((L, DECAY_LORA, A_WIDTH), 0.5 * DECAY_LORA ** -0.5),
        'rwkv_a0': nrm((L, A_WIDTH), 0.1),
        'rwkv_a2': nrm((L, ICLR_LORA, A_WIDTH), ICLR_LORA ** -0.5),
        'rwkv_g2': nrm((L, GATE_LORA, A_WIDTH), GATE_LORA ** -0.5),
        'rwkv_k_k': 0.85 + nrm((L, A_WIDTH), 0.05),
        'rwkv_k_a': 1.0 + nrm((L, A_WIDTH), 0.05),
        'rwkv_r_k': nrm((L, A_HEADS, A_HEAD_DIM), 0.1),
        'rwkv_ln_w': 1.0 + nrm((L, A_WIDTH), 0.02),
        'rwkv_ln_b': nrm((L, A_WIDTH), 0.02),
        'attn_sinks': nrm((L, Q_HEADS), 1.0),
        'w_branch_a': nrm((L, A_WIDTH, D), A_WIDTH ** -0.5),
        'w_branch_b': nrm((L, Q_W, D), Q_W ** -0.5),
        'w_merge_gate': nrm((L, D, 2 * D), D ** -0.5),
        'w_out': nrm((L, D, D), D ** -0.5),
        'final_norm': 1.0 + nrm((D,), 0.02),
    }


def reference(x_prompt, x_sample, c_prompt, c_sample, state_shift, state_wkv, cache_k, cache_v,
              norm_g, w_mod, b_mod, ffn_w_gate, ffn_w_up, ffn_w_down, w_in,
              rwkv_mu, rwkv_w0, rwkv_w2, rwkv_a0, rwkv_a2, rwkv_g2, rwkv_k_k, rwkv_k_a, rwkv_r_k,
              rwkv_ln_w, rwkv_ln_b, attn_sinks, w_branch_a, w_branch_b, w_merge_gate, w_out, final_norm):
    pos_prompt = jnp.arange(SEQ)
    pos_sample = PAST_LEN + jnp.arange(DEC_SEQ)
    zero_shift = jnp.zeros((BATCH, A_PROJ), x_prompt.dtype)
    zero_wkv = jnp.zeros((BATCH, A_HEADS, A_HEAD_DIM, A_HEAD_DIM), jnp.float32)
    xp, xs = x_prompt, x_sample
    sh_p, wk_p, k_p, v_p = [], [], [], []
    sh_s, wk_s, k_s, v_s = [], [], [], []
    for l in range(DEPTH):
        lw = (norm_g[l], w_mod[l], b_mod[l], ffn_w_gate[l], ffn_w_up[l], ffn_w_down[l], w_in[l],
              rwkv_mu[l], rwkv_w0[l], rwkv_w2[l], rwkv_a0[l], rwkv_a2[l], rwkv_g2[l], rwkv_k_k[l],
              rwkv_k_a[l], rwkv_r_k[l], rwkv_ln_w[l], rwkv_ln_b[l], attn_sinks[l],
              w_branch_a[l], w_branch_b[l], w_merge_gate[l], w_out[l])
        xp, a1, a2, a3, a4 = decoder_layer(xp, c_prompt, pos_prompt, zero_shift, zero_wkv, None, None, *lw)
        sh_p.append(a1); wk_p.append(a2); k_p.append(a3); v_p.append(a4)
        xs, b1, b2, b3, b4 = decoder_layer(xs, c_sample, pos_sample, state_shift[l], state_wkv[l], cache_k[l], cache_v[l], *lw)
        sh_s.append(b1); wk_s.append(b2); k_s.append(b3); v_s.append(b4)
    y_prompt = rms_norm(xp, final_norm)
    y_sample = rms_norm(xs, final_norm)
    return (y_prompt, y_sample,
            jnp.stack(sh_p), jnp.stack(wk_p), jnp.stack(k_p), jnp.stack(v_p),
            jnp.stack(sh_s), jnp.stack(wk_s), jnp.stack(k_s), jnp.stack(v_s))
```

```cpp
#include <hip/hip_runtime.h>
#include <cstdio>
#include <cstdint>
#include <cmath>

constexpr int DM = 2048, NBATCH = 4, SEQ = 2048, DEPTH = 2, DBATCH = 128, DSEQ = 4, PAST = 8192;
constexpr int MP = NBATCH * SEQ;
constexpr int MS = DBATCH * DSEQ;
constexpr int MT = MP + MS;
constexpr int NSEQ = NBATCH + DBATCH;
constexpr int AW = 1024, AH = 16, AN = 64, APROJ = 3360, APAD = 3584, QW = 1024, KVW = 256, BPROJ = 1536, WIN = 128, DFF = 5632;
constexpr int NIN = APAD + BPROJ + 2 * DM;
constexpr int NMODC = 9 * DM;
constexpr int MODLD = DEPTH * NMODC;
constexpr int LK = 384, LN3 = 3072;
constexpr float RMS_EPS = 1e-6f, GN_EPS = 64e-5f;

__host__ __device__ __forceinline__ int seq_of_row(int r) { return r < MP ? (r >> 11) : NBATCH + ((r - MP) >> 2); }

constexpr size_t MiB = 1u << 20;
constexpr size_t OFF_CTL = 0, CTL_BYTES = 1 * MiB;
constexpr size_t OFF_WGU = 1 * MiB,   SZ_WGU = (size_t)2 * DFF * DM * 2;
constexpr size_t OFF_WD = OFF_WGU + 4 * SZ_WGU, SZ_WD = (size_t)DM * DFF * 2;
constexpr size_t OFF_WIN = OFF_WD + 4 * SZ_WD, SZ_WIN = (size_t)NIN * DM * 2;
constexpr size_t OFF_WA = OFF_WIN + 2 * SZ_WIN, SZ_WAB = (size_t)DM * AW * 2;
constexpr size_t OFF_WB = OFF_WA + 2 * SZ_WAB;
constexpr size_t OFF_WOUT = OFF_WB + 2 * SZ_WAB, SZ_WOUT = (size_t)DM * DM * 2;
constexpr size_t OFF_WL = OFF_WOUT + 2 * SZ_WOUT, SZ_WL = (size_t)LN3 * LK * 2;
constexpr size_t OFF_AMOD = OFF_WL + 2 * SZ_WL + MiB / 2;
constexpr size_t OFF_MOD = OFF_AMOD + 1 * MiB;
constexpr size_t OFF_X = OFF_MOD + (size_t)256 * MODLD * 4;
constexpr size_t OFF_H = OFF_X + (size_t)MT * DM * 4;
constexpr size_t OFF_R1 = OFF_H + (size_t)MT * DM * 2;
constexpr size_t SZ_R1 = (size_t)MT * 16 * 384 * 4;
constexpr size_t OFF_RHO = OFF_R1;
constexpr size_t OFF_GB = OFF_RHO + (size_t)MT * AW * 4;
constexpr size_t OFF_BV = OFF_GB + (size_t)MT * AW * 2;
constexpr size_t OFF_SEGX = OFF_BV + (size_t)MT * AW * 2;
constexpr size_t OFF_SEGP = OFF_SEGX + (size_t)256 * 4096 * 4;
constexpr size_t OFF_PART = OFF_R1 + 100 * MiB;
static_assert(OFF_SEGP + (size_t)256 * 4096 * 4 <= OFF_PART && (size_t)MT * DFF * 2 <= 100 * MiB && OFF_PART + (size_t)15 * MS * DM * 4 <= OFF_R1 + SZ_R1, "mixer scratch / PART inside R1");
constexpr size_t OFF_PA = OFF_R1 + SZ_R1;
constexpr size_t OFF_MA = OFF_PA, OFF_MRG = OFF_PA + (size_t)MT * DM * 4;
constexpr size_t OFF_PB = OFF_PA + (size_t)MT * APAD * 4;
constexpr size_t OFF_G = OFF_PB + (size_t)MT * BPROJ * 2;
constexpr size_t OFF_LIN = OFF_G + (size_t)MT * 2 * DM * 2;
constexpr size_t OFF_RK = OFF_LIN + (size_t)MT * LK * 2;
constexpr size_t OFF_YA = OFF_RK + (size_t)MT * 16 * 4;
constexpr size_t OFF_YB = OFF_YA + (size_t)MT * AW * 2;
constexpr size_t OFF_WMOD = OFF_YB + (size_t)MT * AW * 2;
constexpr size_t OFF_LOUT = OFF_WMOD, OFF_ORAW = OFF_WMOD + (size_t)MT * LN3 * 4;
constexpr size_t WS_END = OFF_WMOD + (size_t)MODLD * DM * 2;
static_assert(OFF_MRG + (size_t)MT * DM * 2 <= OFF_PB, "MA|MRG overlay PA");
static_assert(OFF_ORAW + (size_t)MT * AW * 4 <= WS_END, "LOUT|ORAW overlay WMOD");
static_assert((size_t)MT * DFF * 2 <= SZ_R1, "T fits R1");
static_assert(OFF_WGU % 256 == 0 && OFF_WD % 256 == 0 && OFF_WIN % 256 == 0 && OFF_WL % 256 == 0 && OFF_AMOD % 256 == 0 && OFF_MOD % 256 == 0 && OFF_X % 256 == 0 && OFF_H % 256 == 0 && OFF_R1 % 256 == 0 &&
              OFF_PA % 256 == 0 && OFF_PB % 256 == 0 && OFF_G % 256 == 0 && OFF_LIN % 256 == 0 && OFF_RK % 256 == 0 && OFF_YA % 256 == 0 && OFF_YB % 256 == 0 && OFF_WMOD % 256 == 0 && OFF_ORAW % 256 == 0 && OFF_MRG % 256 == 0, "alignment");

constexpr size_t OUT_Y = 0;
constexpr size_t OUT_SHP = (size_t)MT * DM;
constexpr size_t OUT_WKP = OUT_SHP + (size_t)DEPTH * NBATCH * APROJ;
constexpr size_t OUT_KP = OUT_WKP + (size_t)DEPTH * NBATCH * AH * AN * AN;
constexpr size_t OUT_VP = OUT_KP + (size_t)DEPTH * NBATCH * WIN * KVW;
constexpr size_t OUT_SHS = OUT_VP + (size_t)DEPTH * NBATCH * WIN * KVW;
constexpr size_t OUT_WKS = OUT_SHS + (size_t)DEPTH * DBATCH * APROJ;
constexpr size_t OUT_KS = OUT_WKS + (size_t)DEPTH * DBATCH * AH * AN * AN;
constexpr size_t OUT_VS = OUT_KS + (size_t)DEPTH * DBATCH * WIN * KVW;
constexpr size_t OUT_END = OUT_VS + (size_t)DEPTH * DBATCH * WIN * KVW;
static_assert(OUT_END == 53315840, "output size");

enum { I_XP = 0, I_XS, I_CP, I_CS, I_SSH, I_SWKV, I_CK, I_CV, I_NG, I_WMOD, I_BMOD, I_FG, I_FU, I_FD, I_WIN, I_MU, I_W0, I_W2, I_A0, I_A2, I_G2, I_KK, I_KA, I_RK, I_LNW, I_LNB, I_SINK, I_WA, I_WB, I_WMG, I_WOUT, I_FN, N_IN };

typedef unsigned short bf16;
#define GAS __attribute__((address_space(1)))
#define LAS __attribute__((address_space(3)))
typedef unsigned v4u __attribute__((ext_vector_type(4)));
typedef unsigned v2u __attribute__((ext_vector_type(2)));
typedef float v4f __attribute__((ext_vector_type(4)));
typedef float v16f __attribute__((ext_vector_type(16)));
typedef short v8s __attribute__((ext_vector_type(8)));
__device__ __forceinline__ unsigned f2bf(float f) { unsigned u = __builtin_bit_cast(unsigned, f); return (u + 0x7fffu + ((u >> 16) & 1u)) >> 16; }
__device__ __forceinline__ unsigned pk2(float lo, float hi) { return f2bf(lo) | (f2bf(hi) << 16); }
__device__ __forceinline__ float bf2f(unsigned h) { return __uint_as_float(h << 16); }
__device__ __forceinline__ float bflo(unsigned w) { return __uint_as_float(w << 16); }
__device__ __forceinline__ float bfhi(unsigned w) { return __uint_as_float(w & 0xffff0000u); }
__device__ __forceinline__ float sigmoidf_(float x) { return 1.0f / (1.0f + __expf(-x)); }
__device__ __forceinline__ float siluf_(float x) { return x / (1.0f + __expf(-x)); }
namespace pg8 {
#define PG8_LAS __attribute__((address_space(3)))
typedef unsigned short bf16_t;
typedef short bf16x8 __attribute__((ext_vector_type(8)));
typedef float f32x4 __attribute__((ext_vector_type(4)));
typedef unsigned u32x4 __attribute__((ext_vector_type(4)));
constexpr int BM = 256, BK = 64, HALF = 128, HTB = HALF * BK * 2  , STAGE_BYTES = 8 * HTB, NXCD = 8, WGM = 8;

__host__ __device__ __forceinline__ int lds_byte(int r, int c) { const int st = (r >> 4) * 2 + (c >> 5), rr = r & 15, cc = c & 31, ob = rr * 64 + cc * 2; return st * 1024 + (ob ^ (((ob >> 9) & 1) << 5)); }
__host__ __device__ __forceinline__ void stage_rc(int b, int& R, int& C) { const int st = b / 1024, sb = b % 1024, swz = sb ^ (((sb >> 9) & 1) << 5); R = (st >> 1) * 16 + swz / 64; C = (st & 1) * 32 + (swz % 64) / 2; }
__host__ __device__ __forceinline__ int perm32(int rho) { const int n = rho >> 4, i = rho & 15; return 8 * (i >> 2) + 4 * n + (i & 3); }

struct Unit { int pm, pn; };     __host__ __device__ __forceinline__ int un_kt0(const Unit& u) { return (u.pn >> 8) & 0xfff; } __host__ __device__ __forceinline__ int un_nkt(const Unit& u) { return (u.pn >> 20) & 0xff; } __host__ __device__ __forceinline__ int un_slice(const Unit& u) { return (u.pn >> 28) & 0xf; }
struct Gemm { const bf16_t* A; const bf16_t* Bt; int M, N, K; const bf16_t* A2; const bf16_t* Bt2; };

struct StaticOrder {
    int nM, nN, nwg, G, c;
    __host__ __device__ __forceinline__ void init(int M, int N, int G_, int c_) { nM = M / BM; nN = N / BM; nwg = nM * nN; G = G_; c = c_; }
    __host__ __device__ __forceinline__ bool next(int i, Unit& u) const {
        const long L = (long)i * G + c; if (L >= nwg) return false;
        int wgid = (int)L; { const int q = nwg / NXCD, r = nwg % NXCD, xcd = wgid % NXCD, off = wgid / NXCD; wgid = (xcd < r ? xcd * (q + 1) : r * (q + 1) + (xcd - r) * q) + off; }
        const int nig = WGM * nN, gid = wgid / nig, fm = gid * WGM, gsz = (nM - fm) < WGM ? (nM - fm) : WGM;
        u.pm = fm + ((wgid % nig) % gsz); u.pn = (wgid % nig) / gsz; return true;
    }
    __device__ __forceinline__ void a_ready(const Unit&) const {}
    __device__ __forceinline__ void done(const Unit&) const {}
};
struct SplitOrder {
    StaticOrder so; int c, ntile, pieces, pk, nkt_all, pm0;
    __host__ __device__ __forceinline__ void init(int Mfull, int Mrest, int N, int K, int G_, int c_, int pieces_, int pk_) { so.init(Mfull, N, G_, c_); c = c_; ntile = (Mrest / BM) * (N / BM); pieces = pieces_; pk = pk_; nkt_all = K / BK; pm0 = Mfull / BM; }
    __host__ __device__ __forceinline__ bool next(int i, Unit& u) const {
        if (i == 0) return so.next(0, u);
        if (i == 1 && c < ntile * pieces) { const int tile = c / pieces, sl = c - tile * pieces; const int nN = so.nN;
            const int kt0 = sl * pk, rem = nkt_all - kt0, nkt = rem < pk ? rem : pk; u.pm = pm0 + tile / nN; u.pn = (tile % nN) | (kt0 << 8) | (nkt << 20) | (sl << 28); return true; }
        return false;
    }
    __device__ __forceinline__ void a_ready(const Unit&) const {}
    __device__ __forceinline__ void done(const Unit&) const {}
};
struct PairOrder {
    StaticOrder so;
    __host__ __device__ __forceinline__ void init(int Mfull, int N, int G_, int c_) { so.init(Mfull, N, G_, c_); }
    __host__ __device__ __forceinline__ bool next(int i, Unit& u) const { if (i > 1) return false; const bool ok = so.next(0, u); u.pm |= (i << 8); return ok; }
    __device__ __forceinline__ void a_ready(const Unit&) const {}
    __device__ __forceinline__ void done(const Unit&) const {}
};

typedef float f32x2_t __attribute__((ext_vector_type(2))); typedef __bf16 bf16x2_t __attribute__((ext_vector_type(2)));
__device__ __forceinline__ unsigned cvt_pk_bf16(float lo, float hi) { const f32x2_t v = {lo, hi}; const bf16x2_t b = __builtin_convertvector(v, bf16x2_t); return __builtin_bit_cast(unsigned, b); }
__device__ __forceinline__ float silu_e(float x) { return x * __builtin_amdgcn_rcpf(1.0f + __expf(-x)); }
__device__ __forceinline__ float sigm_e(float x) { return __builtin_amdgcn_rcpf(1.0f + __expf(-x)); }
__device__ __forceinline__ u32x4 pack8(const f32x4 a, const f32x4 b) { u32x4 w; w.x = cvt_pk_bf16(a[0], a[1]); w.y = cvt_pk_bf16(a[2], a[3]); w.z = cvt_pk_bf16(b[0], b[1]); w.w = cvt_pk_bf16(b[2], b[3]); return w; }

struct EpiSwiGLU {
    static constexpr bool PERM = true, AFTER_DRAIN = false;
    bf16_t* T; int ldt;
    __device__ __forceinline__ void operator()(const f32x4 (&acc)[2][2][4][2], const Unit& u, int wr, int wc, int fr, int fq) const {
        const int row0 = u.pm * BM + wr * 64 + fr, col0 = u.pn * HALF + wc * 32 + 8 * fq;
#pragma unroll
        for (int ai = 0; ai < 2; ++ai)
#pragma unroll
            for (int m = 0; m < 4; ++m) {
                f32x4 o0, o1;
#pragma unroll
                for (int i = 0; i < 4; ++i) { o0[i] = silu_e(acc[ai][0][m][0][i]) * acc[ai][1][m][0][i]; o1[i] = silu_e(acc[ai][0][m][1][i]) * acc[ai][1][m][1][i]; }
                *(u32x4*)(T + (size_t)(row0 + ai * HALF + m * 16) * ldt + col0) = pack8(o0, o1);
            }
    }
};
struct EpiResid {
    static constexpr bool PERM = false, AFTER_DRAIN = false;
    float* X; const float* mod; int moff; float sc; const float* xin;
    __device__ __forceinline__ void operator()(const f32x4 (&acc)[2][2][4][2], const Unit& u, int wr, int wc, int fr, int fq) const {
        const int row0 = u.pm * BM + wr * 64 + fr, col0 = (u.pn & 0xff) * BM + wc * 32 + 4 * fq; const int nkt = un_nkt(u); float* part = (float*)((char*)X + (OFF_PART - OFF_X)) + (size_t)un_slice(u) * MS * DM;
#pragma unroll
        for (int ai = 0; ai < 2; ++ai)
#pragma unroll
            for (int m = 0; m < 4; ++m) { const int row = row0 + ai * HALF + m * 16; const int sq = seq_of_row(row);
                const float* mp = mod + (size_t)sq * MODLD + moff + col0; float* xp = X + (size_t)row * DM + col0;
#pragma unroll
                for (int bj = 0; bj < 2; ++bj)
#pragma unroll
                    for (int n = 0; n < 2; ++n) { const int off = bj * HALF + n * 16; const f32x4 mv = *(const f32x4*)(mp + off);
                        if (nkt == 0) { f32x4 xv = *(const f32x4*)(xin + (size_t)row * DM + col0 + off); xv = xv + (mv * sc) * acc[ai][bj][m][n]; *(f32x4*)(xp + off) = xv; }
                        else { const f32x4 dv = (mv * sc) * acc[ai][bj][m][n];
                            if (sc != 0.f) *(f32x4*)(part + (size_t)(row - MP) * DM + col0 + off) = dv; }     } }
    }
};
struct EpiInProj {
    static constexpr bool PERM = true, AFTER_DRAIN = false;
    float* PA; bf16_t* PB; bf16_t* G;
    __device__ __forceinline__ void operator()(const f32x4 (&acc)[2][2][4][2], const Unit& u, int wr, int wc, int fr, int fq) const {
        const int row0 = u.pm * BM + wr * 64 + fr, cl = wc * 32 + 8 * fq;
        if (u.pn < 14) {
#pragma unroll
            for (int ai = 0; ai < 2; ++ai)
#pragma unroll
                for (int m = 0; m < 4; ++m) { float* p = PA + (size_t)(row0 + ai * HALF + m * 16) * APAD + u.pn * BM + cl;
#pragma unroll
                    for (int bj = 0; bj < 2; ++bj) { *(f32x4*)(p + bj * HALF) = acc[ai][bj][m][0]; *(f32x4*)(p + bj * HALF + 4) = acc[ai][bj][m][1]; } }
        } else if (u.pn < 20) {
#pragma unroll
            for (int ai = 0; ai < 2; ++ai)
#pragma unroll
                for (int m = 0; m < 4; ++m) { bf16_t* p = PB + (size_t)(row0 + ai * HALF + m * 16) * BPROJ + (u.pn - 14) * BM + cl;
#pragma unroll
                    for (int bj = 0; bj < 2; ++bj) *(u32x4*)(p + bj * HALF) = pack8(acc[ai][bj][m][0], acc[ai][bj][m][1]); }
        } else {
#pragma unroll
            for (int ai = 0; ai < 2; ++ai)
#pragma unroll
                for (int m = 0; m < 4; ++m) { bf16_t* p = G + (size_t)(row0 + ai * HALF + m * 16) * (2 * DM) + (u.pn - 20) * BM + cl;
#pragma unroll
                    for (int bj = 0; bj < 2; ++bj) { f32x4 a = acc[ai][bj][m][0], b = acc[ai][bj][m][1];
#pragma unroll
                        for (int i = 0; i < 4; ++i) { a[i] = sigm_e(a[i]); b[i] = sigm_e(b[i]); }
                        *(u32x4*)(p + bj * HALF) = pack8(a, b); } }
        }
    }
};
struct EpiF32 {
    static constexpr bool PERM = false, AFTER_DRAIN = false;
    float* C; int ldc; const float* bias;
    __device__ __forceinline__ void operator()(const f32x4 (&acc)[2][2][4][2], const Unit& u, int wr, int wc, int fr, int fq) const {
        const int row0 = u.pm * BM + wr * 64 + fr, col0 = u.pn * BM + wc * 32 + 4 * fq;
        f32x4 bv[2][2];
#pragma unroll
        for (int bj = 0; bj < 2; ++bj)
#pragma unroll
            for (int n = 0; n < 2; ++n) bv[bj][n] = bias ? *(const f32x4*)(bias + col0 + bj * HALF + n * 16) : (f32x4){0.f, 0.f, 0.f, 0.f};
#pragma unroll
        for (int ai = 0; ai < 2; ++ai)
#pragma unroll
            for (int m = 0; m < 4; ++m) { float* rowp = C + (size_t)(row0 + ai * HALF + m * 16) * ldc + col0;
#pragma unroll
                for (int bj = 0; bj < 2; ++bj)
#pragma unroll
                    for (int n = 0; n < 2; ++n) *(f32x4*)(rowp + bj * HALF + n * 16) = acc[ai][bj][m][n] + bv[bj][n]; }
    }
};
struct EpiBranch {
    static constexpr bool PERM = true, AFTER_DRAIN = false;
    float* MA; const bf16_t* G; bf16_t* MRG;
    __device__ __forceinline__ void operator()(const f32x4 (&acc)[2][2][4][2], const Unit& u, int wr, int wc, int fr, int fq) const {
        const int prob = u.pm >> 8; const int row0 = (u.pm & 0xff) * BM + wr * 64 + fr, col0 = (u.pn & 0xff) * BM + wc * 32 + 8 * fq;
#pragma unroll
        for (int ai = 0; ai < 2; ++ai)
#pragma unroll
            for (int m = 0; m < 4; ++m) { const int row = row0 + ai * HALF + m * 16;
#pragma unroll
                for (int bj = 0; bj < 2; ++bj) { const u32x4 g = *(const u32x4*)(G + (size_t)row * (2 * DM) + (prob ? DM : 0) + col0 + bj * HALF); float* p = MA + (size_t)row * DM + col0 + bj * HALF;
                    f32x4 a = acc[ai][bj][m][0], b = acc[ai][bj][m][1];
                    a[0] *= __uint_as_float(g.x << 16); a[1] *= __uint_as_float(g.x & 0xffff0000u); a[2] *= __uint_as_float(g.y << 16); a[3] *= __uint_as_float(g.y & 0xffff0000u);
                    b[0] *= __uint_as_float(g.z << 16); b[1] *= __uint_as_float(g.z & 0xffff0000u); b[2] *= __uint_as_float(g.w << 16); b[3] *= __uint_as_float(g.w & 0xffff0000u);
                    if (prob == 0) { *(f32x4*)p = a; *(f32x4*)(p + 4) = b; }
                    else { a = a + *(const f32x4*)p; b = b + *(const f32x4*)(p + 4); *(u32x4*)(MRG + (size_t)row * DM + col0 + bj * HALF) = pack8(a, b); } } }
    }
};
template <class Epi, class Sched, bool ALIGN_EPI = false, bool SP2 = false>
__device__ __forceinline__ void gemm_phase(PG8_LAS unsigned char* lds, const Gemm g, const Sched& S, const Epi& E, const int tid) {
    const int wid = __builtin_amdgcn_readfirstlane(tid >> 6), lane = tid & 63, wr = wid >> 2, wc = wid & 3, fr = lane & 15, fq = lane >> 4;
    const int K = g.K, nt_all = K / BK;
    unsigned voffA[2], voffB[2];
#pragma unroll
    for (int i = 0; i < 2; ++i) { int R, C; stage_rc(tid * 16 + i * 8192, R, C); const int Rb = Epi::PERM ? ((R & ~31) + perm32(R & 31)) : R;
        voffA[i] = (unsigned)(R * K + C) * 2u; voffB[i] = (unsigned)(Rb * K + C) * 2u; }
    const size_t kstep = (size_t)(BK * 2);
    const size_t hstep = (size_t)HALF * K * 2;
    const size_t tstep = 2 * hstep;
    const unsigned ldsw = (unsigned)wid * 1024u;
    const int aoff = lds_byte(wr * 64 + fr, fq * 8), boff = lds_byte(wc * 32 + fr, fq * 8);
#define PG8_SA(b, h) (((b) * 2 + (h)) * HTB)
#define PG8_SB(b, h) ((4 + (b) * 2 + (h)) * HTB)
#define PG8_STAGE(bufoff, gbase, voff) do { _Pragma("unroll") for (int _i = 0; _i < 2; ++_i) \
        __builtin_amdgcn_global_load_lds((const unsigned*)((const char*)(gbase) + (voff)[_i]), (PG8_LAS unsigned*)(lds + (bufoff) + ldsw + _i * 8192), 16, 0, 0); } while (0)
#define PG8_LDA(dst, b, h) do { _Pragma("unroll") for (int m = 0; m < 4; ++m) _Pragma("unroll") for (int k = 0; k < 2; ++k) dst[m][k] = *(const PG8_LAS bf16x8*)(lds + PG8_SA(b, h) + aoff + m * 2048 + k * 1024); } while (0)
#define PG8_LDB(dst, b, h) do { _Pragma("unroll") for (int n = 0; n < 2; ++n) _Pragma("unroll") for (int k = 0; k < 2; ++k) dst[n][k] = *(const PG8_LAS bf16x8*)(lds + PG8_SB(b, h) + boff + n * 2048 + k * 1024); } while (0)
#define PG8_MMA(ai, bj, At, Bt) do { __builtin_amdgcn_s_setprio(1); _Pragma("unroll") for (int m = 0; m < 4; ++m) _Pragma("unroll") for (int n = 0; n < 2; ++n) _Pragma("unroll") for (int k = 0; k < 2; ++k) \
        acc[ai][bj][m][n] = __builtin_amdgcn_mfma_f32_16x16x32_bf16(Bt[n][k], At[m][k], acc[ai][bj][m][n], 0, 0, 0); __builtin_amdgcn_s_setprio(0); } while (0)
#define PG8_WAIT_V(n) asm volatile("s_waitcnt vmcnt(" #n ")" ::: "memory")
#define PG8_WAIT_L(n) asm volatile("s_waitcnt lgkmcnt(" #n ")" ::: "memory")
#define PG8_BAR __builtin_amdgcn_s_barrier()
#define PG8_SCHED __builtin_amdgcn_sched_barrier(0)
    Unit cur, nxt; int ui = 0;
    if (!S.next(0, cur)) return;
    f32x4 acc[2][2][4][2];
#pragma unroll
    for (int a = 0; a < 2; ++a)
#pragma unroll
        for (int b = 0; b < 2; ++b)
#pragma unroll
            for (int m = 0; m < 4; ++m)
#pragma unroll
                for (int n = 0; n < 2; ++n) acc[a][b][m][n] = (f32x4){0.f, 0.f, 0.f, 0.f};
    bf16x8 At[4][2], B0[2][2], B1[2][2];
    const char* cA = (const char*)((cur.pm >> 8) ? g.A2 : g.A) + (size_t)(cur.pm & 0xff) * tstep + (size_t)un_kt0(cur) * (BK * 2); const char* cB = (const char*)((cur.pm >> 8) ? g.Bt2 : g.Bt) + (size_t)(cur.pn & 0xff) * tstep + (size_t)un_kt0(cur) * (BK * 2);
    S.a_ready(cur);
    if constexpr (SP2) {
        PG8_STAGE(PG8_SB(0, 0), cB, voffB); PG8_STAGE(PG8_SB(0, 1), cB + hstep, voffB); PG8_STAGE(PG8_SA(0, 0), cA, voffA); PG8_STAGE(PG8_SA(0, 1), cA + hstep, voffA);
        if (wr == 1) PG8_BAR;
        PG8_WAIT_V(2); PG8_BAR;
        PG8_STAGE(PG8_SB(1, 0), cB + kstep, voffB); PG8_STAGE(PG8_SA(1, 0), cA + kstep, voffA); PG8_STAGE(PG8_SB(1, 1), cB + hstep + kstep, voffB);
        PG8_WAIT_V(6); PG8_BAR;
    } else {
        PG8_STAGE(PG8_SB(0, 0), cB, voffB); PG8_STAGE(PG8_SA(0, 0), cA, voffA); PG8_STAGE(PG8_SB(0, 1), cB + hstep, voffB); PG8_STAGE(PG8_SA(0, 1), cA + hstep, voffA);
        if (wr == 1) PG8_BAR;
        PG8_WAIT_V(4); PG8_BAR;
        PG8_STAGE(PG8_SB(1, 0), cB + kstep, voffB); PG8_STAGE(PG8_SA(1, 0), cA + kstep, voffA); PG8_STAGE(PG8_SB(1, 1), cB + hstep + kstep, voffB);
        PG8_WAIT_V(6); PG8_BAR;
    }
    for (;;) {
        const bool has_next = S.next(ui + 1, nxt);
        const char* nA = has_next ? (const char*)((nxt.pm >> 8) ? g.A2 : g.A) + (size_t)(nxt.pm & 0xff) * tstep + (size_t)un_kt0(nxt) * (BK * 2) : cA; const char* nB = has_next ? (const char*)((nxt.pm >> 8) ? g.Bt2 : g.Bt) + (size_t)(nxt.pn & 0xff) * tstep + (size_t)un_kt0(nxt) * (BK * 2) : cB;
        const int nt = un_nkt(cur) ? un_nkt(cur) : nt_all;
        for (int t = 0; t < nt; t += 2) {
            const bool last = (t == nt - 2);
            const char* a1 = cA + (size_t)(t + 1) * kstep;
            const char* a2 = last ? nA : cA + (size_t)(t + 2) * kstep; const char* b2 = last ? nB : cB + (size_t)(t + 2) * kstep;
            const char* a3 = a2 + kstep; const char* b3 = b2 + kstep;
            if (last && has_next) S.a_ready(nxt);
            if constexpr (SP2) {
            PG8_LDB(B0, 0, 0); PG8_LDB(B1, 0, 1); PG8_SCHED; PG8_LDA(At, 0, 0); PG8_STAGE(PG8_SA(1, 1), a1 + hstep, voffA);
            PG8_WAIT_V(8); PG8_WAIT_L(0); PG8_BAR; PG8_MMA(0, 0, At, B0); PG8_MMA(0, 1, At, B1); PG8_BAR; PG8_SCHED;
            PG8_LDA(At, 0, 1); PG8_STAGE(PG8_SB(0, 0), b2, voffB); PG8_STAGE(PG8_SB(0, 1), b2 + hstep, voffB); PG8_STAGE(PG8_SA(0, 0), a2, voffA);
            PG8_WAIT_V(8); PG8_WAIT_L(0); PG8_BAR; PG8_MMA(1, 0, At, B0); PG8_MMA(1, 1, At, B1); PG8_BAR; PG8_SCHED;
            PG8_LDB(B0, 1, 0); PG8_LDB(B1, 1, 1); PG8_SCHED; PG8_LDA(At, 1, 0); PG8_STAGE(PG8_SA(0, 1), a2 + hstep, voffA);
            PG8_WAIT_V(8); PG8_WAIT_L(0); PG8_BAR; PG8_MMA(0, 0, At, B0); PG8_MMA(0, 1, At, B1); PG8_BAR; PG8_SCHED;
            PG8_LDA(At, 1, 1); PG8_STAGE(PG8_SB(1, 0), b3, voffB); PG8_STAGE(PG8_SB(1, 1), b3 + hstep, voffB); PG8_STAGE(PG8_SA(1, 0), a3, voffA);
            PG8_WAIT_V(8); PG8_WAIT_L(0); PG8_BAR; PG8_MMA(1, 0, At, B0); PG8_MMA(1, 1, At, B1); PG8_BAR; PG8_SCHED;
            } else {
            PG8_LDB(B0, 0, 0); PG8_SCHED; PG8_LDA(At, 0, 0); PG8_STAGE(PG8_SA(1, 1), a1 + hstep, voffA);
            PG8_WAIT_L(8); PG8_BAR; PG8_WAIT_L(0); PG8_MMA(0, 0, At, B0); PG8_BAR; PG8_SCHED;
            PG8_LDB(B1, 0, 1); PG8_STAGE(PG8_SB(0, 0), b2, voffB);
            PG8_BAR; PG8_WAIT_L(0); PG8_MMA(0, 1, At, B1); PG8_BAR;
            PG8_LDA(At, 0, 1); PG8_STAGE(PG8_SA(0, 0), a2, voffA);
            PG8_BAR; PG8_WAIT_L(0); PG8_MMA(1, 0, At, B0); PG8_BAR; PG8_SCHED;
            PG8_STAGE(PG8_SB(0, 1), b2 + hstep, voffB);
            PG8_WAIT_V(6); PG8_BAR; PG8_MMA(1, 1, At, B1); PG8_BAR;
            PG8_LDB(B0, 1, 0); PG8_SCHED; PG8_LDA(At, 1, 0); PG8_STAGE(PG8_SA(0, 1), a2 + hstep, voffA);
            PG8_WAIT_L(8); PG8_BAR; PG8_WAIT_L(0); PG8_MMA(0, 0, At, B0); PG8_BAR; PG8_SCHED;
            PG8_LDB(B1, 1, 1); PG8_STAGE(PG8_SB(1, 0), b3, voffB);
            PG8_BAR; PG8_WAIT_L(0); PG8_MMA(0, 1, At, B1); PG8_BAR;
            PG8_LDA(At, 1, 1); PG8_STAGE(PG8_SA(1, 0), a3, voffA);
            PG8_BAR; PG8_WAIT_L(0); PG8_MMA(1, 0, At, B0); PG8_BAR; PG8_SCHED;
            PG8_STAGE(PG8_SB(1, 1), b3 + hstep, voffB);
            PG8_WAIT_V(6); PG8_BAR; PG8_MMA(1, 1, At, B1); PG8_BAR;
            }
        }
        if constexpr (ALIGN_EPI) { if (wr == 0) PG8_BAR; }
        if constexpr (!Epi::AFTER_DRAIN) { E(acc, cur, wr, wc, fr, fq); S.done(cur); }
        if (!has_next) break;
#pragma unroll
        for (int a = 0; a < 2; ++a)
#pragma unroll
            for (int b = 0; b < 2; ++b)
#pragma unroll
                for (int m = 0; m < 4; ++m)
#pragma unroll
                    for (int n = 0; n < 2; ++n) acc[a][b][m][n] = (f32x4){0.f, 0.f, 0.f, 0.f};
        cur = nxt; cA = nA; cB = nB; ++ui;
        if constexpr (ALIGN_EPI) { if (wr == 1) PG8_BAR; }
    }
    PG8_WAIT_V(0);
    if constexpr (!ALIGN_EPI) { if (wr == 0) PG8_BAR; }
    PG8_BAR;
    if constexpr (Epi::AFTER_DRAIN) { E.fused(acc, cur, wr, wc, fr, fq, lds, wid, lane); S.done(cur); }
#undef PG8_SA
#undef PG8_SB
#undef PG8_STAGE
#undef PG8_LDA
#undef PG8_LDB
#undef PG8_MMA
#undef PG8_WAIT_V
#undef PG8_WAIT_L
#undef PG8_BAR
#undef PG8_SCHED
}
}
#define XB_TMO      128
#define XB_XCNT(j)  (256  + 64 * (j))
#define XB_XSUB(j)  (1280 + 64 * (j))
#define XB_XGEN(j)  (2304 + 64 * (j))
#define XB_TOP      3328
#define XB_TOPGEN   3392
#define XCD_BAR_WORDS 3456
#define XB_SPIN_CAP (1u << 18)

__device__ __forceinline__ unsigned xb_ld(unsigned* p)              { return __hip_atomic_load(p, __ATOMIC_RELAXED, __HIP_MEMORY_SCOPE_AGENT); }
__device__ __forceinline__ unsigned xb_add(unsigned* p, unsigned v) { return __hip_atomic_fetch_add(p, v, __ATOMIC_RELAXED, __HIP_MEMORY_SCOPE_AGENT); }
__device__ __forceinline__ unsigned xb_xcc_id() { return (unsigned)__builtin_amdgcn_s_getreg((3 << 11) | 20) & 0xFu; }
#define XB_SPIN(cond, bar) do { unsigned _sp = 0; while (cond) { __builtin_amdgcn_s_sleep(1); \
    if ((++_sp & 255u) == 0u) { if (xb_ld(&(bar)[XB_TMO])) break; if (_sp > XB_SPIN_CAP) { atomicAdd(&(bar)[XB_TMO], 1u); break; } } } } while (0)

struct XcdBarrier {
    unsigned* bar; unsigned x;
    volatile LAS unsigned* st;
};

__device__ __forceinline__ XcdBarrier xcd_barrier_post(unsigned* bar, volatile LAS unsigned* st) {
    XcdBarrier b; b.bar = bar; b.x = xb_xcc_id(); b.st = st;
    if (threadIdx.x == 0) (void)xb_add(&bar[XB_XCNT(b.x)], 1u);
    return b;
}
__device__ __forceinline__ void xcd_barrier_complete(unsigned* bar, unsigned x, unsigned& nloc, unsigned& nx) {
    const unsigned G = gridDim.x * gridDim.y * gridDim.z;
    unsigned sum, cnt, mine, sp = 0u;
    for (;;) {
        sum = 0u; cnt = 0u; mine = 0u;
#pragma unroll
        for (unsigned j = 0; j < 16; ++j) { const unsigned c = xb_ld(&bar[XB_XCNT(j)]); sum += c; cnt += (c > 0u) ? 1u : 0u; mine = (j == x) ? c : mine; }
        if (sum == G) break;
        __builtin_amdgcn_s_sleep(1);
        if ((++sp & 255u) == 0u) { if (xb_ld(&bar[XB_TMO])) break; if (sp > XB_SPIN_CAP) { atomicAdd(&bar[XB_TMO], 1u); break; } }
    }
    nloc = mine > 0u ? mine : 1u; nx = cnt > 0u ? cnt : 1u;
}

__device__ __forceinline__ void xcd_barrier_census(const XcdBarrier& b) {
    if (threadIdx.x == 0) { unsigned nloc, nx; xcd_barrier_complete(b.bar, b.x, nloc, nx); b.st[0] = nloc; b.st[1] = nx; }
    __syncthreads();
}
__device__ __forceinline__ void xcd_barrier(const XcdBarrier& b) {
    asm volatile("s_waitcnt vmcnt(0)" ::: "memory");
    __syncthreads();
    if (threadIdx.x == 0) {
        unsigned* bar = b.bar;
        __builtin_amdgcn_s_waitcnt(0);
        unsigned nloc = b.st[0], nx = b.st[1];
        const unsigned old = xb_add(&bar[XB_XSUB(b.x)], 1u);
        const unsigned gen = old / nloc;
        if (old + 1u == (gen + 1u) * nloc) {
            __builtin_amdgcn_fence(__ATOMIC_RELEASE, "agent");
            asm volatile("s_waitcnt vmcnt(0)" ::: "memory");
            const unsigned og = xb_add(&bar[XB_TOP], 1u);
            const unsigned tg = og / nx;
            if (og + 1u == (tg + 1u) * nx) xb_add(&bar[XB_TOPGEN], 1u);
            else XB_SPIN(xb_ld(&bar[XB_TOPGEN]) == tg, bar);
            __builtin_amdgcn_fence(__ATOMIC_ACQUIRE, "agent");
            xb_add(&bar[XB_XGEN(b.x)], 1u);
            asm volatile("s_waitcnt vmcnt(0)" ::: "memory");
        } else {
            XB_SPIN(xb_ld(&bar[XB_XGEN(b.x)]) == gen, bar);
            __builtin_amdgcn_fence(__ATOMIC_ACQUIRE, "agent");
            asm volatile("s_waitcnt vmcnt(0)" ::: "memory");
        }
    }
    __syncthreads();
}

constexpr int RING_OFF = 0, RING_BYTES = 131072;
constexpr int LDSCTL_OFF = 159744, MISC_OFF = LDSCTL_OFF + 320;
constexpr int LDS_BYTES = 163840;
constexpr int NWAVES = 8;

#define RLX_AGENT __ATOMIC_RELAXED, __HIP_MEMORY_SCOPE_AGENT
#define WS_DPP(v, ctrl) __int_as_float(__builtin_amdgcn_update_dpp(0, __float_as_int(v), (ctrl), 0xF, 0xF, true))
__device__ __forceinline__ float wave_sum(float v) {
    v += WS_DPP(v, 0xB1); v += WS_DPP(v, 0x4E); v += WS_DPP(v, 0x141); v += WS_DPP(v, 0x140);
    return (__int_as_float(__builtin_amdgcn_readlane(__float_as_int(v), 0)) + __int_as_float(__builtin_amdgcn_readlane(__float_as_int(v), 16))) + (__int_as_float(__builtin_amdgcn_readlane(__float_as_int(v), 32)) + __int_as_float(__builtin_amdgcn_readlane(__float_as_int(v), 48)));
}
__device__ __forceinline__ float wave_max(float v) {
#pragma unroll
    for (int o = 1; o < 64; o <<= 1) v = fmaxf(v, __shfl_xor(v, o));
    return v;
}
__device__ __forceinline__ float ld_agent(const float* p) { return __uint_as_float(__hip_atomic_load((const unsigned*)p, RLX_AGENT)); }

struct Args { const float* in[N_IN]; float* out; unsigned char* ws; int ph_lo, ph_hi, use_bar, pad; };
constexpr int PTAB_OFF = LDSCTL_OFF + 1024;
__device__ __forceinline__ const float* inp_ptr(int i) { extern __shared__ __attribute__((aligned(16))) unsigned char lds_raw_[]; const LAS unsigned* t = (const LAS unsigned*)((LAS unsigned char*)lds_raw_ + PTAB_OFF) + 2 * i;
    const unsigned lo = __builtin_amdgcn_readfirstlane(t[0]), hi = __builtin_amdgcn_readfirstlane(t[1]); return (const float*)(const GAS float*)(((unsigned long long)hi << 32) | lo); }
#define INP(i) inp_ptr(i)


__device__ __forceinline__ void cvt_item(const float* __restrict__ W, int N, bf16* WT, int ldk, int k0, int n0, int drow0, LAS float* scr, int lane) {
    const int rr = lane >> 3, c4 = (lane & 7) * 4;
#pragma unroll
    for (int i = 0; i < 8; ++i) { const int kk = 8 * i + rr; const v4f v = *(const v4f*)(W + (size_t)(k0 + kk) * N + n0 + c4); LAS float* d = scr + kk * 33 + c4; d[0] = v.x; d[1] = v.y; d[2] = v.z; d[3] = v.w; }
    asm volatile("s_waitcnt lgkmcnt(0)" ::: "memory");
    const int c = lane & 7;
#pragma unroll
    for (int j = 0; j < 4; ++j) { const int n = (lane >> 3) + 8 * j; const LAS float* s = scr + (8 * c) * 33 + n;
        v4u o; o.x = pk2(s[0 * 33], s[1 * 33]); o.y = pk2(s[2 * 33], s[3 * 33]); o.z = pk2(s[4 * 33], s[5 * 33]); o.w = pk2(s[6 * 33], s[7 * 33]);
        *(v4u*)(WT + (size_t)(drow0 + n) * ldk + k0 + 8 * c) = o; }
    asm volatile("s_waitcnt lgkmcnt(0)" ::: "memory");
}
__device__ __forceinline__ void p0_phase(const Args& a, LAS unsigned char* lds, int vcu, int G, int wave, int lane) {
    LAS float* scr = (LAS float*)(lds + wave * 16384);
    const int gw = vcu * NWAVES + wave, NGW = G * NWAVES;
    unsigned char* ws = a.ws;
    constexpr int I_GU = (DM / 64) * (DFF / 32), I_D = (DFF / 64) * (DM / 32), I_IN = (DM / 64) * (4896 / 32), I_MG = (DM / 64) * (2 * DM / 32), I_AB = (AW / 64) * (DM / 32), I_OUT = (DM / 64) * (DM / 32), I_MOD = (DM / 64) * (NMODC / 32);
    constexpr int I_LAYER = 4 * I_GU + 2 * I_D + I_IN + I_MG + 2 * I_AB + I_OUT;
    for (int it = gw; it < DEPTH * I_LAYER; it += NGW) {
        const int l = it / I_LAYER; int r = it - l * I_LAYER;
        if (r < 4 * I_GU) { const int which = r / I_GU, f = which & 1, up = which >> 1; r -= which * I_GU; const int nb = DFF / 32, kb = r / nb, n0 = 32 * (r % nb);
            cvt_item(INP(up ? I_FU : I_FG) + (size_t)(l * 2 + f) * DM * DFF, DFF, (bf16*)(ws + OFF_WGU + (size_t)(l * 2 + f) * SZ_WGU), DM, 64 * kb, n0, 256 * (n0 >> 7) + (n0 & 127) + 128 * up, scr, lane); continue; } r -= 4 * I_GU;
        if (r < 2 * I_D) { const int f = r / I_D; r -= f * I_D; const int nb = DM / 32, kb = r / nb, n0 = 32 * (r % nb);
            cvt_item(INP(I_FD) + (size_t)(l * 2 + f) * DFF * DM, DM, (bf16*)(ws + OFF_WD + (size_t)(l * 2 + f) * SZ_WD), DFF, 64 * kb, n0, n0, scr, lane); continue; } r -= 2 * I_D;
        if (r < I_IN) { const int nb = 4896 / 32, kb = r / nb, n0 = 32 * (r % nb);
            cvt_item(INP(I_WIN) + (size_t)l * DM * 4896, 4896, (bf16*)(ws + OFF_WIN + (size_t)l * SZ_WIN), DM, 64 * kb, n0, n0 < APROJ ? n0 : n0 + (APAD - APROJ), scr, lane); continue; } r -= I_IN;
        if (r < I_MG) { const int nb = 2 * DM / 32, kb = r / nb, n0 = 32 * (r % nb);
            cvt_item(INP(I_WMG) + (size_t)l * DM * 2 * DM, 2 * DM, (bf16*)(ws + OFF_WIN + (size_t)l * SZ_WIN), DM, 64 * kb, n0, APAD + BPROJ + n0, scr, lane); continue; } r -= I_MG;
        if (r < 2 * I_AB) { const int wb = r / I_AB; r -= wb * I_AB; const int nb = DM / 32, kb = r / nb, n0 = 32 * (r % nb);
            cvt_item(INP(wb ? I_WB : I_WA) + (size_t)l * AW * DM, DM, (bf16*)(ws + (wb ? OFF_WB : OFF_WA) + (size_t)l * SZ_WAB), AW, 64 * kb, n0, n0, scr, lane); continue; } r -= 2 * I_AB;
        { const int nb = DM / 32, kb = r / nb, n0 = 32 * (r % nb);
            cvt_item(INP(I_WOUT) + (size_t)l * DM * DM, DM, (bf16*)(ws + OFF_WOUT + (size_t)l * SZ_WOUT), DM, 64 * kb, n0, n0, scr, lane); }
    }
    const int gt = gw * 64 + lane, NGT = NGW * 64;
    { bf16* A = (bf16*)(ws + OFF_AMOD);
      for (int i = gt; i < 256 * DM; i += NGT) { const int row = i >> 11, c = i & (DM - 1); float v = 0.f;
          if (row < NBATCH) v = siluf_(INP(I_CP)[row * DM + c]); else if (row < NSEQ) v = siluf_(INP(I_CS)[(row - NBATCH) * DM + c]);
          A[i] = (bf16)f2bf(v); } }
    for (int i = gt; i < DEPTH * LN3 * LK; i += NGT) { const int l = i / (LN3 * LK), rem = i - l * (LN3 * LK), row = rem / LK, k = rem - row * LK; float v = 0.f;
        if (row < 1024) { if (k < 64) v = INP(I_W2)[((size_t)l * 64 + k) * AW + row]; }
        else if (row < 2048) { if (k >= 64 && k < 128) v = INP(I_A2)[((size_t)l * 64 + (k - 64)) * AW + (row - 1024)]; }
        else { if (k >= 128 && k < 288) v = INP(I_G2)[((size_t)l * 160 + (k - 128)) * AW + (row - 2048)]; }
        ((bf16*)(ws + OFF_WL))[i] = (bf16)f2bf(v); }
    for (int i = gt; i < DEPTH * (APAD - APROJ) * DM / 8; i += NGT) { const int l = i / ((APAD - APROJ) * DM / 8), rem = i - l * ((APAD - APROJ) * DM / 8);
        *(v4u*)(ws + OFF_WIN + (size_t)l * SZ_WIN + (size_t)APROJ * DM * 2 + (size_t)rem * 16) = (v4u){0u, 0u, 0u, 0u}; }
}

__device__ __forceinline__ void norm_phase(float* X, const float* gain, const float* MOD, int moff_shift, int moff_scale, bf16* H, int gw, int NGW, int lane, const float* part, int nparts, const float* xp0, const float* xs0) {
    for (int row = gw; row < MT; row += NGW) {
        v4f* xr = (v4f*)(X + (size_t)row * DM) + lane; v4f v[8]; float ss = 0.f;
        const v4f* xsrc = row < MP ? (xp0 ? (const v4f*)(xp0 + (size_t)row * DM) + lane : xr) : (xs0 ? (const v4f*)(xs0 + (size_t)(row - MP) * DM) + lane : xr);
#pragma unroll
        for (int j = 0; j < 8; ++j) v[j] = xsrc[64 * j];
        if (row >= MP && nparts > 0) {
            for (int s = 0; s < nparts; ++s) { const v4f* pr = (const v4f*)(part + ((size_t)s * MS + (row - MP)) * DM) + lane;
#pragma unroll
                for (int j = 0; j < 8; ++j) v[j] = v[j] + pr[64 * j]; }
#pragma unroll
            for (int j = 0; j < 8; ++j) xr[64 * j] = v[j]; }
#pragma unroll
        for (int j = 0; j < 8; ++j) { ss += (v[j].x * v[j].x + v[j].y * v[j].y) + (v[j].z * v[j].z + v[j].w * v[j].w); }
        const float rstd = 1.0f / sqrtf(wave_sum(ss) * (1.0f / DM) + RMS_EPS);
        const int sq = seq_of_row(row);
        const v4f* sh = (const v4f*)(MOD + (size_t)sq * MODLD + moff_shift) + lane; const v4f* sc = (const v4f*)(MOD + (size_t)sq * MODLD + moff_scale) + lane; const v4f* gp = (const v4f*)gain + lane;
        v2u* o8 = (v2u*)(H + (size_t)row * DM) + lane;
#pragma unroll
        for (int j = 0; j < 8; ++j) { const v4f g = gp[64 * j], s = sc[64 * j], h = sh[64 * j]; const v4f y = v[j] * rstd * g * (s + 1.0f) + h;
            v2u w; w.x = pk2(y.x, y.y); w.y = pk2(y.z, y.w); o8[64 * j] = w; }
    }
}
__device__ __forceinline__ void final_norm_phase(const float* X, const float* gain, float* out, int gw, int NGW, int lane, const float* part, int nparts) {
    for (int row = gw; row < MT; row += NGW) {
        const v4f* xr = (const v4f*)(X + (size_t)row * DM) + lane; v4f v[8]; float ss = 0.f;
#pragma unroll
        for (int j = 0; j < 8; ++j) v[j] = xr[64 * j];
        if (row >= MP) { for (int s = 0; s < nparts; ++s) { const v4f* pr = (const v4f*)(part + ((size_t)s * MS + (row - MP)) * DM) + lane;
#pragma unroll
                for (int j = 0; j < 8; ++j) v[j] = v[j] + pr[64 * j]; } }
#pragma unroll
        for (int j = 0; j < 8; ++j) { ss += (v[j].x * v[j].x + v[j].y * v[j].y) + (v[j].z * v[j].z + v[j].w * v[j].w); }
        const float rstd = 1.0f / sqrtf(wave_sum(ss) * (1.0f / DM) + RMS_EPS);
        const v4f* gp = (const v4f*)gain + lane; v4f* o = (v4f*)(out + (size_t)row * DM) + lane;
#pragma unroll
        for (int j = 0; j < 8; ++j) o[64 * j] = v[j] * rstd * gp[64 * j];
    }
}

struct Tok { int prompt, b, t, first, last, pos; };
__device__ __forceinline__ Tok tok_of(int row) { Tok k; if (row < MP) { k.prompt = 1; k.b = row >> 11; k.t = row & (SEQ - 1); k.first = k.t == 0; k.last = k.t == SEQ - 1; k.pos = k.t; }
    else { const int r = row - MP; k.prompt = 0; k.b = r >> 2; k.t = r & 3; k.first = k.t == 0; k.last = k.t == DSEQ - 1; k.pos = PAST + k.t; } return k; }
__device__ __forceinline__ size_t sc_record(const Tok& k, int h) { return k.prompt ? ((size_t)(k.b * AH + h) * SEQ + k.t) : ((size_t)NBATCH * AH * SEQ + (size_t)(k.b * AH + h) * DSEQ + k.t); }

__device__ __forceinline__ void e1_phase(const Args& a, int l, int gw, int NGW, int lane, bool do_rope) {
    unsigned char* ws = a.ws; const float* PA = (const float*)(ws + OFF_PA); bf16* PB = (bf16*)(ws + OFF_PB); bf16* LIN = (bf16*)(ws + OFF_LIN);
    const float* mu = INP(I_MU) + (size_t)l * APROJ;
    for (int row = gw; row < MT; row += NGW) {
        const Tok k = tok_of(row);
        const float* pa = PA + (size_t)row * APAD;
        const float* pv = k.first ? (k.prompt ? nullptr : INP(I_SSH) + ((size_t)l * DBATCH + k.b) * APROJ) : pa - APAD;
#pragma unroll
        for (int i = 0; i < 3; ++i) { const int p = lane + 64 * i;
            if (p < 160 && do_rope) { const int hd = p >> 3, i8 = p & 7; const int col = (hd < 16 ? hd * 64 : QW + (hd - 16) * 64) + i8;
                bf16* q = PB + (size_t)row * BPROJ + col; const float x1 = bf2f(q[0]), x2 = bf2f(q[8]);
                const float inv = exp2f(-(float)i8 * (18.931568569324174f / 8.0f)); const float ang = (float)k.pos * inv; float sn, cs; sincosf(ang, &sn, &cs);
                q[0] = (bf16)f2bf(x1 * cs - x2 * sn); q[8] = (bf16)f2bf(x2 * cs + x1 * sn); } }
        if (k.last) { float* o = a.out + (k.prompt ? OUT_SHP + ((size_t)l * NBATCH + k.b) * APROJ : OUT_SHS + ((size_t)l * DBATCH + k.b) * APROJ);
            for (int c = lane; c < APROJ; c += 64) o[c] = pa[c]; }
    }
}
__device__ __forceinline__ void e2_phase(const Args& a, int l, int gw, int NGW, int lane) {
    unsigned char* ws = a.ws; const float* PA = (const float*)(ws + OFF_PA); const float* LOUT = (const float*)(ws + OFF_LOUT); float* SC = (float*)(ws + OFF_R1); float* RK = (float*)(ws + OFF_RK);
    const float* mu = INP(I_MU) + (size_t)l * APROJ; const float* w0 = INP(I_W0) + l * AW; const float* a0 = INP(I_A0) + l * AW; const float* k_k = INP(I_KK) + l * AW; const float* k_a = INP(I_KA) + l * AW; const float* r_k = INP(I_RK) + l * AW;
    for (int row = gw; row < MT; row += NGW) {
        const Tok k = tok_of(row);
        const float* pa = PA + (size_t)row * APAD;
        const float* pv = k.first ? (k.prompt ? nullptr : INP(I_SSH) + ((size_t)l * DBATCH + k.b) * APROJ) : pa - APAD;
        const float* lo = LOUT + (size_t)row * LN3;
        for (int h = 0; h < AH; ++h) { const int col = h * 64 + lane;
            float xr = pa[col], xk = pa[AW + col], xv = pa[2 * AW + col];
            const float pr = pv ? pv[col] : 0.f, pk = pv ? pv[AW + col] : 0.f, pvv = pv ? pv[2 * AW + col] : 0.f;
            xr += (pr - xr) * mu[col]; xk += (pk - xk) * mu[AW + col]; xv += (pvv - xv) * mu[2 * AW + col];
            const float w = w0[col] + lo[col]; const float av = sigmoidf_(a0[col] + lo[AW + col]);
            const float nw = -w; const float sp = fmaxf(nw, 0.f) + log1pf(expf(-fabsf(nw)));
            const float dec = expf(-expf(-sp - 0.5f));
            float kk = xk * k_k[col]; const float n2 = wave_sum(kk * kk); kk = kk / fmaxf(sqrtf(n2), 1e-12f);
            const float kp = xk * (1.0f + (av - 1.0f) * k_a[col]); const float bb = kk * av;
            const float rk = wave_sum(xr * kp * r_k[col]);
            float* rec = SC + sc_record(k, h) * 384;
            rec[lane] = xr; rec[64 + lane] = dec; rec[128 + lane] = kp; rec[192 + lane] = kk; rec[256 + lane] = bb; rec[320 + lane] = xv;
            if (lane == 0) RK[(size_t)row * AH + h] = rk; }
    }
}
__device__ __forceinline__ void e3_items(const Args& a, int l, int first, int step, int lane) {
    unsigned char* ws = a.ws; const float* LOUT = (const float*)(ws + OFF_LOUT); const float* SC = (const float*)(ws + OFF_R1); const float* RK = (const float*)(ws + OFF_RK); const float* ORAW = (const float*)(ws + OFF_ORAW); bf16* YA = (bf16*)(ws + OFF_YA);
    const float* lnw = INP(I_LNW) + l * AW; const float* lnb = INP(I_LNB) + l * AW;
    for (int row = first; row < MT; row += step) {
        const Tok k = tok_of(row);
        for (int h = 0; h < AH; ++h) { const int col = h * 64 + lane;
            const float o = ORAW[(size_t)row * AW + col]; const float mean = wave_sum(o) * (1.0f / 64.0f); const float dv = o - mean; const float var = wave_sum(dv * dv) * (1.0f / 64.0f);
            const float on = dv * (1.0f / sqrtf(var + GN_EPS)) * lnw[col] + lnb[col];
            const float v = SC[sc_record(k, h) * 384 + 320 + lane]; const float rk = ld_agent(RK + (size_t)row * AH + h); const float g = LOUT[(size_t)row * LN3 + 2 * AW + col];
            YA[(size_t)row * AW + col] = (bf16)f2bf((on + rk * v) * g); }
    }
}

__device__ __forceinline__ float dpp_x1(float v) { return __int_as_float(__builtin_amdgcn_update_dpp(0, __float_as_int(v), 0xB1, 0xF, 0xF, true)); }
__device__ __forceinline__ float dpp_x2(float v) { return __int_as_float(__builtin_amdgcn_update_dpp(0, __float_as_int(v), 0x4E, 0xF, 0xF, true)); }
#define SCAN_STEP(LD4, VI, OUT) do { \
    v4f kk_[4], b_[4], d_[4], k_[4], r_[4]; \
    _Pragma("unroll") for (int q_ = 0; q_ < 4; ++q_) { r_[q_] = LD4(0, q_); d_[q_] = LD4(64, q_); k_[q_] = LD4(128, q_); kk_[q_] = LD4(192, q_); b_[q_] = LD4(256, q_); } \
    float sk_ = 0.f; _Pragma("unroll") for (int q_ = 0; q_ < 4; ++q_) sk_ += (S[q_].x * kk_[q_].x + S[q_].y * kk_[q_].y) + (S[q_].z * kk_[q_].z + S[q_].w * kk_[q_].w); \
    sk_ += dpp_x1(sk_); sk_ += dpp_x2(sk_); \
    const float vi_ = (VI); float o_ = 0.f; \
    _Pragma("unroll") for (int q_ = 0; q_ < 4; ++q_) { S[q_] = S[q_] * d_[q_] - b_[q_] * sk_ + k_[q_] * vi_; o_ += (S[q_].x * r_[q_].x + S[q_].y * r_[q_].y) + (S[q_].z * r_[q_].z + S[q_].w * r_[q_].w); } \
    o_ += dpp_x1(o_); o_ += dpp_x2(o_); (OUT) = o_; } while (0)

__device__ __forceinline__ void scan_phase(const Args& a, int l, LAS unsigned char* lds, int vcu, int G, int wave, int lane) {
    unsigned char* ws = a.ws; const float* SC = (const float*)(ws + OFF_R1); float* ORAW = (float*)(ws + OFF_ORAW);
    const int ri = lane >> 2, jq = lane & 3;
    if (wave == 0) {
        for (int task = vcu; task < NBATCH * AH * 4; task += G) {
            const int bh = task >> 2, rq = task & 3, i = 16 * rq + ri, b = bh >> 4, h = bh & 15;
            const char* src = (const char*)(SC + (size_t)bh * SEQ * 384);
            v4f S[4]; S[0] = S[1] = S[2] = S[3] = (v4f){0.f, 0.f, 0.f, 0.f};
            constexpr int NBLK = SEQ / 2, NSLOT = 8, BLKB = 3072;
#define SCAN_ISSUE(blk) do { const char* g_ = src + (size_t)(blk) * BLKB + lane * 16; const unsigned so_ = (unsigned)((blk) & (NSLOT - 1)) * BLKB; \
            _Pragma("unroll") for (int i_ = 0; i_ < 3; ++i_) __builtin_amdgcn_global_load_lds((const unsigned*)(g_ + i_ * 1024), (LAS unsigned*)(lds + so_ + i_ * 1024), 16, 0, 0); } while (0)
            for (int blk = 0; blk < NSLOT; ++blk) SCAN_ISSUE(blk);
            float* op = ORAW + ((size_t)b * SEQ) * AW + h * 64 + i;
            for (int blk = 0; blk < NBLK; ++blk) {
                if (blk < NBLK - (NSLOT - 1)) asm volatile("s_waitcnt vmcnt(21)" ::: "memory"); else asm volatile("s_waitcnt vmcnt(0)" ::: "memory");
                const LAS float* slot = (const LAS float*)(lds + (unsigned)(blk & (NSLOT - 1)) * BLKB);
#pragma unroll
                for (int st = 0; st < 2; ++st) { const LAS float* p = slot + st * 384; float o;
#define LD4_LDS(off, q) (*(const LAS v4f*)(p + (off) + 16 * jq + 4 * (q)))
                    SCAN_STEP(LD4_LDS, p[320 + i], o);
#undef LD4_LDS
                    if (jq == 0) op[(size_t)(2 * blk + st) * AW] = o; }
                asm volatile("s_waitcnt lgkmcnt(0)" ::: "memory");
                if (blk + NSLOT < NBLK) SCAN_ISSUE(blk + NSLOT);
            }
#undef SCAN_ISSUE
            asm volatile("s_waitcnt vmcnt(0)" ::: "memory");
            float* so = a.out + OUT_WKP + (((size_t)(l * NBATCH + b) * AH + h) * AN + i) * AN + 16 * jq;
#pragma unroll
            for (int q = 0; q < 4; ++q) *(v4f*)(so + 4 * q) = S[q];
        }
    } else {
        const int sw = vcu * (NWAVES - 1) + (wave - 1), NSW = G * (NWAVES - 1);
        for (int task = sw; task < DBATCH * AH * 4; task += NSW) {
            const int bh = task >> 2, rq = task & 3, i = 16 * rq + ri, b = bh >> 4, h = bh & 15;
            const size_t sidx = (((size_t)(l * DBATCH + b) * AH + h) * AN + i) * AN + 16 * jq;
            const float* sp = INP(I_SWKV) + sidx; v4f S[4];
#pragma unroll
            for (int q = 0; q < 4; ++q) S[q] = *(const v4f*)(sp + 4 * q);
            const float* rec = SC + ((size_t)NBATCH * AH * SEQ + (size_t)bh * DSEQ) * 384;
            float* op = ORAW + ((size_t)MP + b * DSEQ) * AW + h * 64 + i;
#pragma unroll
            for (int st = 0; st < DSEQ; ++st) { const float* p = rec + st * 384; float o;
#define LD4_G(off, q) (*(const v4f*)(p + (off) + 16 * jq + 4 * (q)))
                SCAN_STEP(LD4_G, p[320 + i], o);
#undef LD4_G
                if (jq == 0) op[(size_t)st * AW] = o; }
            float* so = a.out + OUT_WKS + sidx;
#pragma unroll
            for (int q = 0; q < 4; ++q) *(v4f*)(so + 4 * q) = S[q];
        }
    }
}

__device__ __forceinline__ void attn_phase(const Args& a, int l, LAS unsigned char* lds, int gw, int NGW, int wave, int lane) {
    unsigned char* ws = a.ws; const bf16* PB = (const bf16*)(ws + OFF_PB); bf16* YB = (bf16*)(ws + OFF_YB);
    LAS bf16* Vt = (LAS bf16*)(lds + wave * 8192);
    LAS float* linv = (LAS float*)(lds + wave * 8192 + 4096);
    LAS float* pbuf = (LAS float*)(lds + wave * 8192 + 4096 + 256);
    const int c31 = lane & 31, hh = lane >> 5;
    const float* sinks = INP(I_SINK) + l * AH;
    for (int item = gw; item < NBATCH * AH * (SEQ / 32); item += NGW) {
        const int b = item >> 10, h = (item >> 6) & 15, qb = item & 63, kvh = h >> 2, q0 = qb * 32, rowbase = b * SEQ;
        v8s qf[4]; { const bf16* qp = PB + (size_t)(rowbase + q0 + c31) * BPROJ + h * 64 + 8 * hh;
#pragma unroll
            for (int s = 0; s < 4; ++s) qf[s] = *(const v8s*)(qp + 16 * s); }
        v16f S[5]; float mx = -INFINITY;
#pragma unroll
        for (int tile = 0; tile < 5; ++tile) { const int kt0 = q0 - WIN + 32 * tile;
            if (kt0 < 0) {
#pragma unroll
                for (int r = 0; r < 16; ++r) S[tile][r] = -INFINITY;
            } else {
                const bf16* kp = PB + (size_t)(rowbase + kt0 + c31) * BPROJ + QW + kvh * 64 + 8 * hh; v16f acc;
#pragma unroll
                for (int r = 0; r < 16; ++r) acc[r] = 0.f;
#pragma unroll
                for (int s = 0; s < 4; ++s) { const v8s kf = *(const v8s*)(kp + 16 * s); acc = __builtin_amdgcn_mfma_f32_32x32x16_bf16(kf, qf[s], acc, 0, 0, 0); }
#pragma unroll
                for (int r = 0; r < 16; ++r) { const int key = kt0 + (r & 3) + 8 * (r >> 2) + 4 * hh; const int diff = q0 + c31 - key; const bool ok = diff >= 0 && diff < WIN;
                    const float s = ok ? acc[r] * 0.125f : -INFINITY; S[tile][r] = s; mx = fmaxf(mx, s); }
            } }
        mx = fmaxf(mx, __shfl_xor(mx, 32)); const float sink = sinks[h]; mx = fmaxf(mx, sink);
        float sum = 0.f;
#pragma unroll
        for (int tile = 0; tile < 5; ++tile)
#pragma unroll
            for (int r = 0; r < 16; ++r) { const float p = __expf(S[tile][r] - mx); S[tile][r] = p; sum += p; }
        sum += __shfl_xor(sum, 32); sum += __expf(sink - mx);
        if (lane < 32) linv[lane] = 1.0f / sum;
        v16f O0, O1;
#pragma unroll
        for (int r = 0; r < 16; ++r) { O0[r] = 0.f; O1[r] = 0.f; }
#pragma unroll
        for (int tile = 0; tile < 5; ++tile) { const int kt0 = q0 - WIN + 32 * tile;
            if (kt0 >= 0) {
#pragma unroll
                for (int i = 0; i < 4; ++i) { const int idx = i * 64 + lane, key = idx >> 3, ch = idx & 7;
                    *(LAS v4u*)(Vt + key * 64 + ch * 8) = *(const v4u*)(PB + (size_t)(rowbase + kt0 + key) * BPROJ + QW + KVW + kvh * 64 + ch * 8); }
#pragma unroll
                for (int s = 0; s < 2; ++s) { v8s pf;
#pragma unroll
                    for (int j = 0; j < 8; j += 2) { const unsigned w = pk2(S[tile][8 * s + j], S[tile][8 * s + j + 1]); pf[j] = (short)(w & 0xffffu); pf[j + 1] = (short)(w >> 16); }
                    v8s v0, v1;
#pragma unroll
                    for (int j = 0; j < 8; ++j) { const int key = 16 * s + 8 * (j >> 2) + 4 * hh + (j & 3); v0[j] = (short)Vt[key * 64 + c31]; v1[j] = (short)Vt[key * 64 + 32 + c31]; }
                    O0 = __builtin_amdgcn_mfma_f32_32x32x16_bf16(pf, v0, O0, 0, 0, 0); O1 = __builtin_amdgcn_mfma_f32_32x32x16_bf16(pf, v1, O1, 0, 0, 0); }
            } }
#pragma unroll
        for (int r = 0; r < 16; ++r) { const int q = (r & 3) + 8 * (r >> 2) + 4 * hh; const float li = linv[q]; bf16* yp = YB + (size_t)(rowbase + q0 + q) * QW + h * 64 + c31;
            yp[0] = (bf16)f2bf(O0[r] * li); yp[32] = (bf16)f2bf(O1[r] * li); }
    }
    LAS float* qs = pbuf + 132 * 4;
    for (int item = gw; item < DBATCH * AH; item += NGW) {
        const int b = item >> 4, h = item & 15, kvh = h >> 2; const int row0 = MP + b * DSEQ;
        const float* ck = INP(I_CK) + (((size_t)l * DBATCH + b) * WIN) * KVW + kvh * 64; const float* cv = INP(I_CV) + (((size_t)l * DBATCH + b) * WIN) * KVW + kvh * 64;
#pragma unroll
        for (int t = 0; t < 4; ++t) qs[t * 64 + lane] = bf2f(PB[(size_t)(row0 + t) * BPROJ + h * 64 + lane]);
        float s0[4] = {0.f, 0.f, 0.f, 0.f}, s1[4] = {0.f, 0.f, 0.f, 0.f}, s2[4] = {0.f, 0.f, 0.f, 0.f};
        const float* k0p = ck + (size_t)lane * KVW; const float* k1p = ck + (size_t)(lane + 64) * KVW; const bf16* k2p = PB + (size_t)(row0 + (lane & 3)) * BPROJ + QW + kvh * 64;
        for (int d = 0; d < 64; d += 4) { const v4f ka = *(const v4f*)(k0p + d), kb = *(const v4f*)(k1p + d); const v2u kc = *(const v2u*)(k2p + d); const float c0 = bflo(kc.x), c1 = bfhi(kc.x), c2 = bflo(kc.y), c3 = bfhi(kc.y);
#pragma unroll
            for (int t = 0; t < 4; ++t) { const v4f q = *(const LAS v4f*)(qs + t * 64 + d);
                s0[t] += (ka.x * q.x + ka.y * q.y) + (ka.z * q.z + ka.w * q.w); s1[t] += (kb.x * q.x + kb.y * q.y) + (kb.z * q.z + kb.w * q.w); s2[t] += (c0 * q.x + c1 * q.y) + (c2 * q.z + c3 * q.w); } }
        const float sink = sinks[h];
#pragma unroll
        for (int t = 0; t < 4; ++t) {
            const float a0 = (lane >= t + 1) ? s0[t] * 0.125f : -INFINITY;
            const float a1 = s1[t] * 0.125f;
            const float a2 = (lane < 4 && lane <= t) ? s2[t] * 0.125f : -INFINITY;
            const float m = fmaxf(wave_max(fmaxf(fmaxf(a0, a1), a2)), sink);
            const float p0 = __expf(a0 - m), p1 = __expf(a1 - m), p2 = __expf(a2 - m);
            const float inv = 1.0f / (wave_sum(p0 + p1 + p2) + __expf(sink - m));
            pbuf[lane * 4 + t] = p0 * inv; pbuf[(lane + 64) * 4 + t] = p1 * inv; if (lane < 4) pbuf[(128 + lane) * 4 + t] = p2 * inv; }
        float o[4] = {0.f, 0.f, 0.f, 0.f};
        for (int key = 0; key < WIN; ++key) { const float v = cv[(size_t)key * KVW + lane]; const v4f p = *(const LAS v4f*)(pbuf + key * 4); o[0] += p.x * v; o[1] += p.y * v; o[2] += p.z * v; o[3] += p.w * v; }
#pragma unroll
        for (int t2 = 0; t2 < 4; ++t2) { const float v = bf2f(PB[(size_t)(row0 + t2) * BPROJ + QW + KVW + kvh * 64 + lane]); const v4f p = *(const LAS v4f*)(pbuf + (128 + t2) * 4); o[0] += p.x * v; o[1] += p.y * v; o[2] += p.z * v; o[3] += p.w * v; }
#pragma unroll
        for (int t = 0; t < 4; ++t) YB[(size_t)(row0 + t) * QW + h * 64 + lane] = (bf16)f2bf(o[t]);
    }
    for (int item = gw; item < NSEQ * WIN; item += NGW) { const int sq = item >> 7, w = item & (WIN - 1);
        if (sq < NBATCH) { const bf16* src = PB + (size_t)(sq * SEQ + SEQ - WIN + w) * BPROJ + QW + lane * 4;
            const v2u kx = *(const v2u*)src, vx = *(const v2u*)(src + KVW);
            *(v4f*)(a.out + OUT_KP + (((size_t)l * NBATCH + sq) * WIN + w) * KVW + lane * 4) = (v4f){bflo(kx.x), bfhi(kx.x), bflo(kx.y), bfhi(kx.y)};
            *(v4f*)(a.out + OUT_VP + (((size_t)l * NBATCH + sq) * WIN + w) * KVW + lane * 4) = (v4f){bflo(vx.x), bfhi(vx.x), bflo(vx.y), bfhi(vx.y)}; }
        else { const int b = sq - NBATCH; v4f kx, vx;
            if (w < WIN - DSEQ) { kx = *(const v4f*)(INP(I_CK) + (((size_t)l * DBATCH + b) * WIN + w + DSEQ) * KVW + lane * 4); vx = *(const v4f*)(INP(I_CV) + (((size_t)l * DBATCH + b) * WIN + w + DSEQ) * KVW + lane * 4); }
            else { const bf16* src = PB + (size_t)(MP + b * DSEQ + (w - (WIN - DSEQ))) * BPROJ + QW + lane * 4; const v2u k2 = *(const v2u*)src, v2 = *(const v2u*)(src + KVW);
                kx = (v4f){bflo(k2.x), bfhi(k2.x), bflo(k2.y), bfhi(k2.y)}; vx = (v4f){bflo(v2.x), bfhi(v2.x), bflo(v2.y), bfhi(v2.y)}; }
            *(v4f*)(a.out + OUT_KS + (((size_t)l * DBATCH + b) * WIN + w) * KVW + lane * 4) = kx;
            *(v4f*)(a.out + OUT_VS + (((size_t)l * DBATCH + b) * WIN + w) * KVW + lane * 4) = vx; }
    }
}

namespace mix {
using pg8::sigm_e; using pg8::f32x2_t; using pg8::bf16x2_t;
constexpr int CH = 32;
constexpr int NSEG = 4, SEGLEN = SEQ / NSEG, SEGCH = SEGLEN / CH;
constexpr int L_LIN = 0;
constexpr int L_LO = 18944;
constexpr int L_KR = 0;
constexpr int L_BK = L_KR + 9216;
constexpr int L_VW = L_BK + 9216;
constexpr int L_A2 = L_VW + 9216;
constexpr int L_MKK = L_A2 + 9216;
constexpr int L_MRB = L_MKK + 2560;
constexpr int L_LT = L_MRB + 4608;
constexpr int L_YK = L_LT + 4608;
constexpr int L_Y1 = L_YK + 8320;
constexpr int L_W1F = L_Y1 + 8320;
constexpr int L_W2T = L_W1F + 8320;
constexpr int L_W2P = L_W2T + 5120;
constexpr int L_RTP = L_W2P + 4608;
constexpr int L_EG = L_RTP + 4608;
constexpr int L_PS = L_EG + 256;
constexpr int L_RAW = L_PS + 2048;
constexpr int RAWW = 480;
constexpr int L_END = L_RAW + 33 * RAWW * 4;
static_assert(L_LO + 3 * 32 * 65 * 4 <= L_EG && L_END <= LDSCTL_OFF, "MIX-A LDS map");
#define MIX_BAR() asm volatile("s_waitcnt lgkmcnt(0)\n\ts_barrier" ::: "memory")
__device__ __forceinline__ v4f mfma16(v8s a, v8s b, v4f c) { return __builtin_amdgcn_mfma_f32_16x16x32_bf16(a, b, c, 0, 0, 0); }
__device__ __forceinline__ bf16 bf1(float x) { return __builtin_bit_cast(unsigned short, (__bf16)x); }
__device__ __forceinline__ unsigned pkbf(float lo, float hi) { const f32x2_t v = {lo, hi}; const bf16x2_t b = __builtin_convertvector(v, bf16x2_t); return __builtin_bit_cast(unsigned, b); }
__device__ __forceinline__ int fpos(int idx) { return 8 * ((idx & 15) >> 2) + 4 * ((idx >> 4) & 1) + (idx & 3) + (idx & ~31); }
__device__ __forceinline__ float tanh_e(float x) { return 1.0f - 2.0f * __builtin_amdgcn_rcpf(__expf(2.0f * x) + 1.0f); }

template <int T0> __device__ __forceinline__ void fsub_blk(LAS float* XS, const LAS float* LT, int lane) {
    if constexpr (T0 < 32) {
        float acc[4];
#pragma unroll
        for (int e = 0; e < 4; ++e) acc[e] = XS[(T0 + e) * 65 + lane];
#pragma unroll
        for (int g = 0; g < T0 / 4; ++g) { float xs[4];
#pragma unroll
            for (int k = 0; k < 4; ++k) xs[k] = XS[(4 * g + k) * 65 + lane];
#pragma unroll
            for (int e = 0; e < 4; ++e) { const v4f l4 = *(const LAS v4f*)(LT + (T0 + e) * 36 + 4 * g); acc[e] = __builtin_fmaf(-l4.x, xs[0], acc[e]); acc[e] = __builtin_fmaf(-l4.y, xs[1], acc[e]); acc[e] = __builtin_fmaf(-l4.z, xs[2], acc[e]); acc[e] = __builtin_fmaf(-l4.w, xs[3], acc[e]); } }
        const v4f t1 = *(const LAS v4f*)(LT + (T0 + 1) * 36 + T0), t2 = *(const LAS v4f*)(LT + (T0 + 2) * 36 + T0), t3 = *(const LAS v4f*)(LT + (T0 + 3) * 36 + T0);
        const float x0 = acc[0], x1 = acc[1] - t1.x * x0, x2 = acc[2] - t2.x * x0 - t2.y * x1, x3 = acc[3] - t3.x * x0 - t3.y * x1 - t3.z * x2;
        XS[T0 * 65 + lane] = x0; XS[(T0 + 1) * 65 + lane] = x1; XS[(T0 + 2) * 65 + lane] = x2; XS[(T0 + 3) * 65 + lane] = x3;
        fsub_blk<T0 + 4>(XS, LT, lane);
    }
}

__device__ __forceinline__ size_t o0_frag(int row, int h, int nt) { return ((size_t)((row >> 4) * AH + h) * 4 + nt) * 256; }

struct Job { int row0, nchunks, nvalid, h, l; const float* prev0; const float* state_in; float* state_out; int seg_slot; };

template <int MODE>
__device__ __forceinline__ void run_job(const Args& a, const Job jb_, LAS unsigned char* lds, int tid) {
    constexpr bool FULL = MODE == 0, SAMPLE = MODE == 1;
    unsigned char* ws = a.ws; const float* PA = (const float*)(ws + OFF_PA);
    const int lane = tid & 63, wave = __builtin_amdgcn_readfirstlane(tid >> 6), q = lane >> 4, c16 = lane & 15;
    const int jb = lane, tg = wave;
    const int h = jb_.h, l = jb_.l, col = h * 64 + jb;
    const float* mu = INP(I_MU) + (size_t)l * APROJ;
    const float* cw0 = INP(I_W0) + l * AW; const float* ca0 = INP(I_A0) + l * AW; const float* ckk = INP(I_KK) + l * AW; const float* cka = INP(I_KA) + l * AW; const float* crk = INP(I_RK) + l * AW;
    const int mt = wave >> 2, nt = wave & 3;
    LAS bf16* LIN = (LAS bf16*)(lds + L_LIN); LAS float* LO = (LAS float*)(lds + L_LO); LAS float* PS = (LAS float*)(lds + L_PS);
    constexpr int nvalid = CH; const int b0 = jb_.row0;
    const float* shiftb = SAMPLE ? INP(I_SSH) + (size_t)l * DBATCH * APROJ : nullptr;
    v4f xt[4];
    if (FULL) { const int cs = wave;
#pragma unroll
        for (int jt = 0; jt < 4; ++jt)
#pragma unroll
            for (int r = 0; r < 4; ++r) xt[jt][r] = (cs >= 4 && 16 * jt + 4 * q + r == 16 * (cs - 4) + c16) ? 1.f : 0.f; }
    LAS float* RAW = (LAS float*)(lds + L_RAW);
#define MIX_PREFETCH_DMA(CHN) do { const int rowc_ = SAMPLE ? 0 : jb_.row0 + (CHN) * CH; const float* pa_ = PA + (size_t)rowc_ * APAD; const float* pv_ = ((CHN) == 0) ? jb_.prev0 : pa_ - APAD; \
        _Pragma("unroll 1") for (int k_ = 0; k_ < 8; ++k_) { const int ki_ = wave + 8 * k_; const int p_ = 64 * ki_ + lane; const int row_ = p_ / 120, c4_ = p_ - row_ * 120; \
            const int scol_ = c4_ < 48 ? (c4_ >> 4) * AW + h * 64 + 4 * (c4_ & 15) : 3072 + 4 * (c4_ - 48); \
            const bool act_ = p_ < 33 * 120 && (row_ == 0 ? (!SAMPLE && pv_ != nullptr) : true); const int tl_ = row_ - 1; \
            const float* src_ = (row_ == 0 ? pv_ : (SAMPLE ? PA + (size_t)(MP + 4 * (b0 + 16 * (tl_ >> 2)) + (tl_ & 3)) * APAD : pa_ + (size_t)tl_ * APAD)) + scol_; \
            if (ki_ < 62 && act_) __builtin_amdgcn_global_load_lds((const unsigned*)src_, (LAS unsigned*)(lds + L_RAW + 1024 * ki_), 16, 0, 0); } \
        if (!SAMPLE && pv_ == nullptr && tid < 120) { float z_ = 0.f; asm volatile("" : "+v"(z_)); *(LAS v4f*)(RAW + 4 * tid) = (v4f){z_, z_, z_, z_}; } } while (0)
    MIX_BAR();
    MIX_PREFETCH_DMA(0);
    for (int ch = 0; ch < jb_.nchunks; ++ch) {
        const int rowc = SAMPLE ? 0 : jb_.row0 + ch * CH;
        if (ch == 0) asm volatile("s_waitcnt vmcnt(0)" ::: "memory"); else asm volatile("s_waitcnt vmcnt(16)" ::: "memory");
        MIX_BAR();
#pragma unroll 1
        for (int i = 0; i < 5; ++i) { const int vi = tid + 512 * i;
            if (vi < 2304) { const int t = vi / 72, cv = vi - t * 72; const int tt = t;
                const v4f cur = *(const LAS v4f*)(RAW + (tt + 1) * RAWW + 192 + 4 * cv); v4f prv;
                if (SAMPLE && (t & 3) == 0) prv = *(const v4f*)(shiftb + (size_t)(b0 + 16 * (t >> 2)) * APROJ + 3072 + 4 * cv); else prv = *(const LAS v4f*)(RAW + tt * RAWW + 192 + 4 * cv);
                const v4f m = *(const v4f*)(mu + 3072 + 4 * cv); v4f xm = cur + (prv - cur) * m;
                if (cv < 16) { xm.x = tanh_e(xm.x); xm.y = tanh_e(xm.y); xm.z = tanh_e(xm.z); xm.w = tanh_e(xm.w); }
                else if (cv >= 32) { xm.x = sigm_e(xm.x); xm.y = sigm_e(xm.y); xm.z = sigm_e(xm.z); xm.w = sigm_e(xm.w); }
                v2u w; w.x = pkbf(xm.x, xm.y); w.y = pkbf(xm.z, xm.w); *(LAS v2u*)(LIN + t * 296 + 4 * cv) = w; } }
        int colx = col; asm volatile("" : "+v"(colx));
        const float mu_r = mu[colx], mu_k = mu[AW + colx], mu_v = mu[2 * AW + colx];
        const float w0c = cw0[colx], a0c = ca0[colx], kkc = ckk[colx], kac = cka[colx], rkc = crk[colx];
        float rm[4], km[4], vm[4];
#pragma unroll
        for (int r = 0; r < 4; ++r) { const int tt = 4 * tg + r; const LAS float* cp = RAW + (tt + 1) * RAWW + jb; const LAS float* pp = cp - RAWW; float p0, p1, p2;
            if (SAMPLE && r == 0) { const float* sp = shiftb + (size_t)(b0 + 16 * tg) * APROJ + colx; p0 = sp[0]; p1 = sp[AW]; p2 = sp[2 * AW]; } else { p0 = pp[0]; p1 = pp[64]; p2 = pp[128]; }
            rm[r] = cp[0] + (p0 - cp[0]) * mu_r; km[r] = cp[64] + (p1 - cp[64]) * mu_k; vm[r] = cp[128] + (p2 - cp[128]) * mu_v; }
        MIX_BAR();
        if (ch + 1 < jb_.nchunks) MIX_PREFETCH_DMA(ch + 1);
        {           v8s bw[2], ba[2], bg[5];
          { const bf16* WL = (const bf16*)(ws + OFF_WL + (size_t)l * SZ_WL); const int n = h * 64 + 16 * nt + c16;
#pragma unroll
            for (int ks = 0; ks < 2; ++ks) { bw[ks] = *(const v8s*)(WL + (size_t)n * LK + 32 * ks + 8 * q); ba[ks] = *(const v8s*)(WL + (size_t)(AW + n) * LK + 64 + 32 * ks + 8 * q); }
#pragma unroll
            for (int ks = 0; ks < 5; ++ks) bg[ks] = *(const v8s*)(WL + (size_t)(2 * AW + n) * LK + 128 + 32 * ks + 8 * q); }
          v4f cw = {0.f, 0.f, 0.f, 0.f}, ca = cw, cg = cw; const LAS bf16* ap = LIN + (16 * mt + c16) * 296 + 8 * q;
#pragma unroll
          for (int ks = 0; ks < 2; ++ks) { cw = mfma16(*(const LAS v8s*)(ap + 32 * ks), bw[ks], cw); ca = mfma16(*(const LAS v8s*)(ap + 64 + 32 * ks), ba[ks], ca); }
#pragma unroll
          for (int ks = 0; ks < 5; ++ks) cg = mfma16(*(const LAS v8s*)(ap + 128 + 32 * ks), bg[ks], cg);
#pragma unroll
          for (int r = 0; r < 4; ++r) { const int o = (16 * mt + 4 * q + r) * 65 + 16 * nt + c16; LO[o] = cw[r]; LO[32 * 65 + o] = ca[r]; LO[2 * 32 * 65 + o] = cg[r]; } }
        MIX_BAR();
        float ldv[4], kkn[4], kp[4], bb[4], gv[4], rkv[4];
#pragma unroll
        for (int r = 0; r < 4; ++r) { const int t = 4 * tg + r; const bool ok = t < nvalid;
            const float w = w0c + LO[t * 65 + jb], av = sigm_e(a0c + LO[32 * 65 + t * 65 + jb]); gv[r] = LO[2 * 32 * 65 + t * 65 + jb];
            const float nw = -w; const float sp = fmaxf(nw, 0.f) + __logf(1.0f + __expf(-fabsf(nw)));
            ldv[r] = ok ? -__expf(-sp - 0.5f) : 0.f;
            const float kk = km[r] * kkc; const float n2 = wave_sum(kk * kk); kkn[r] = kk * __builtin_amdgcn_rsqf(fmaxf(n2, 1e-24f));
            const float kpv = km[r] * (1.0f + (av - 1.0f) * kac); rkv[r] = wave_sum(rm[r] * kpv * rkc);
            kp[r] = ok ? kpv : 0.f; bb[r] = ok ? kkn[r] * av : 0.f; if (!ok) vm[r] = 0.f; }
#define MIX_ROW(t_) (SAMPLE ? MP + 4 * (b0 + 16 * ((t_) >> 2)) + ((t_) & 3) : rowc + (t_))
        if (SAMPLE) {
            bf16* GB = (bf16*)(ws + OFF_GB); bf16* BV = (bf16*)(ws + OFF_BV); float* O0 = (float*)(ws + OFF_ORAW); LAS float* REC = RAW;
#pragma unroll
            for (int r = 0; r < 4; ++r) { const int t = 4 * tg + r; const size_t row = MIX_ROW(t); GB[row * AW + col] = bf1(gv[r]); BV[row * AW + col] = bf1(rkv[r] * vm[r]);
                LAS float* rec = REC + t * 384 + jb; rec[0] = rm[r]; rec[64] = __expf(ldv[r]); rec[128] = kp[r]; rec[192] = kkn[r]; rec[256] = bb[r]; rec[320] = vm[r]; }
            MIX_BAR();
            const int ri = lane >> 2, jq = lane & 3;
            for (int task = wave; task < 32; task += NWAVES) { const int k = task >> 2, rq = task & 3, i = 16 * rq + ri; const int b = b0 + 16 * k;
                const size_t sidx = (((size_t)(l * DBATCH + b) * AH + h) * AN + i) * AN + 16 * jq; const float* sp = INP(I_SWKV) + sidx; v4f S[4];
#pragma unroll
                for (int qq = 0; qq < 4; ++qq) S[qq] = *(const v4f*)(sp + 4 * qq);
#pragma unroll
                for (int st = 0; st < DSEQ; ++st) { const LAS float* p = REC + (4 * k + st) * 384; float o;
#define LD4_L(off, qq) (*(const LAS v4f*)(p + (off) + 16 * jq + 4 * (qq)))
                    SCAN_STEP(LD4_L, p[320 + i], o);
#undef LD4_L
                    if (jq == 0) { const int row = MP + 4 * b + st; O0[o0_frag(row, h, i >> 4) + (size_t)(16 * ((row & 15) >> 2) + (i & 15)) * 4 + (row & 3)] = o; } }
                float* so = a.out + OUT_WKS + sidx;
#pragma unroll
                for (int qq = 0; qq < 4; ++qq) *(v4f*)(so + 4 * qq) = S[qq]; }
        }
        if (FULL) {
            bf16* GB = (bf16*)(ws + OFF_GB); bf16* BV = (bf16*)(ws + OFF_BV); float* O0 = (float*)(ws + OFF_ORAW); float* RHO = (float*)(ws + OFF_RHO);
            LAS bf16* KR = (LAS bf16*)(lds + L_KR); LAS bf16* BK = (LAS bf16*)(lds + L_BK); LAS bf16* VW = (LAS bf16*)(lds + L_VW); LAS bf16* A2 = (LAS bf16*)(lds + L_A2);
            LAS bf16* MKK = (LAS bf16*)(lds + L_MKK); LAS bf16* MRB = (LAS bf16*)(lds + L_MRB); LAS float* LT = (LAS float*)(lds + L_LT); LAS float* YK = (LAS float*)(lds + L_YK);
            LAS float* EG = (LAS float*)(lds + L_EG); LAS float* Y1 = (LAS float*)(lds + L_Y1); LAS float* W1F = (LAS float*)(lds + L_W1F);
            LAS bf16* W2T = (LAS bf16*)(lds + L_W2T); LAS bf16* W2P = (LAS bf16*)(lds + L_W2P); LAS bf16* RTP = (LAS bf16*)(lds + L_RTP);
#pragma unroll
            for (int r = 0; r < 4; ++r) { const int t = 4 * tg + r; if (t < nvalid) { GB[(size_t)(rowc + t) * AW + col] = bf1(gv[r]); BV[(size_t)(rowc + t) * AW + col] = bf1(rkv[r] * vm[r]); } }
            const float c0 = ldv[0], c1 = c0 + ldv[1], c2 = c1 + ldv[2], c3 = c2 + ldv[3];
            PS[tg * 64 + jb] = c3;
            MIX_BAR();
            { float off = 0.f, tot = 0.f;
#pragma unroll
              for (int w = 0; w < 8; ++w) { const float p = PS[w * 64 + jb]; tot += p; off += (w < tg) ? p : 0.f; }
              const float gc[4] = {off + c0, off + c1, off + c2, off + c3};
              float eG[4], eGm1[4];
#pragma unroll
              for (int r = 0; r < 4; ++r) eG[r] = __expf(gc[r]);
              eGm1[0] = __expf(off); eGm1[1] = eG[0]; eGm1[2] = eG[1]; eGm1[3] = eG[2];
              const float eT = __expf(tot);
              float ktv[4], btv[4];
#pragma unroll
              for (int r = 0; r < 4; ++r) { const int t = 4 * tg + r; const float inv = __builtin_amdgcn_rcpf(eG[r]); const float kh = kkn[r] * eGm1[r];
                  KR[t * 72 + jb] = bf1(kh); KR[(32 + t) * 72 + jb] = bf1(rm[r] * eG[r]); BK[t * 72 + jb] = bf1(bb[r] * inv); BK[(32 + t) * 72 + jb] = bf1(kp[r] * inv);
                  YK[t * 65 + jb] = kh; ktv[r] = kp[r] * (eT * inv); btv[r] = bb[r] * (eT * inv); }
              v2u w; w.x = pkbf(vm[0], vm[1]); w.y = pkbf(vm[2], vm[3]); *(LAS v2u*)(VW + jb * 72 + 4 * tg) = w;
              w.x = pkbf(ktv[0], ktv[1]); w.y = pkbf(ktv[2], ktv[3]); *(LAS v2u*)(A2 + jb * 72 + 4 * tg) = w;
              w.x = pkbf(btv[0], btv[1]); w.y = pkbf(btv[2], btv[3]); *(LAS v2u*)(A2 + jb * 72 + 32 + 8 * (tg & 3) + 4 * (tg >> 2)) = w;
              if (tg == 0) EG[jb] = eT; }
            MIX_BAR();
            { const int mt4 = wave >> 1, ntp = wave & 1; v4f m0 = {0.f, 0.f, 0.f, 0.f}, m1 = m0;
#pragma unroll
              for (int ks = 0; ks < 2; ++ks) { const v8s af = *(const LAS v8s*)(KR + (16 * mt4 + c16) * 72 + 32 * ks + 8 * q);
                  m0 = mfma16(af, *(const LAS v8s*)(BK + (32 * ntp + c16) * 72 + 32 * ks + 8 * q), m0); m1 = mfma16(af, *(const LAS v8s*)(BK + (32 * ntp + 16 + c16) * 72 + 32 * ks + 8 * q), m1); }
#pragma unroll
              for (int tile = 0; tile < 2; ++tile)
#pragma unroll
                  for (int r = 0; r < 4; ++r) { const float val = tile ? m1[r] : m0[r]; const int t = (16 * mt4 + 4 * q + r) & 31, s = 16 * tile + c16;
                      if (mt4 < 2) { if (ntp == 0) LT[t * 36 + s] = (s < t) ? val : 0.f; else MKK[t * 40 + s] = bf1((s < t) ? val : 0.f); }
                      else { if (ntp == 0) MRB[t * 72 + 32 + s] = bf1((s <= t) ? -val : 0.f); else MRB[t * 72 + s] = bf1((s <= t) ? val : 0.f); } } }
            MIX_BAR();
            { v4f y = {0.f, 0.f, 0.f, 0.f}; y = mfma16(*(const LAS v8s*)(MKK + (16 * mt + c16) * 40 + 8 * q), *(const LAS v8s*)(VW + (16 * nt + c16) * 72 + 8 * q), y);
#pragma unroll
              for (int r = 0; r < 4; ++r) Y1[(16 * mt + 4 * q + r) * 65 + 16 * nt + c16] = y[r]; }
            MIX_BAR();
            if (wave < 2) { LAS float* XS = wave == 0 ? YK : Y1;
#ifndef NO_FSUB
                fsub_blk<0>(XS, LT, lane);
#endif
                if (wave == 0) { const int pj = fpos(lane);
#pragma unroll
                    for (int t8 = 0; t8 < 32; t8 += 8) { float x[8];
#pragma unroll
                        for (int e = 0; e < 8; ++e) x[e] = XS[(t8 + e) * 65 + lane];
                        v4u w; w.x = pkbf(x[0], x[1]); w.y = pkbf(x[2], x[3]); w.z = pkbf(x[4], x[5]); w.w = pkbf(x[6], x[7]); *(LAS v4u*)(W2T + lane * 40 + t8) = w;
#pragma unroll
                        for (int e = 0; e < 8; ++e) W2P[(t8 + e) * 72 + pj] = bf1(x[e]); }
                } else {
#pragma unroll
                    for (int t8 = 0; t8 < 32; t8 += 8) { float x[8];
#pragma unroll
                        for (int e = 0; e < 8; ++e) x[e] = XS[(t8 + e) * 65 + lane];
                        v4u w; w.x = pkbf(x[0], x[1]); w.y = pkbf(x[2], x[3]); w.z = pkbf(x[4], x[5]); w.w = pkbf(x[6], x[7]); *(LAS v4u*)(VW + lane * 72 + 32 + t8) = w;
#pragma unroll
                        for (int e = 0; e < 8; ++e) W1F[(t8 + e) * 65 + lane] = x[e]; }
                } }
            MIX_BAR();
            { v4f c;
#pragma unroll
              for (int r = 0; r < 4; ++r) c[r] = bf2f(KR[(32 + 16 * mt + 4 * q + r) * 72 + 16 * nt + c16]);
              c = mfma16(*(const LAS v8s*)(MRB + (16 * mt + c16) * 72 + 32 + 8 * q), *(const LAS v8s*)(W2T + (16 * nt + c16) * 40 + 8 * q), c);
              const int pj = fpos(16 * nt + c16);
#pragma unroll
              for (int r = 0; r < 4; ++r) RTP[(16 * mt + 4 * q + r) * 72 + pj] = bf1(c[r]); }
            MIX_BAR();
#ifndef MIXDBG_NO8
            { const int cs = wave; v8s xf[2];
#pragma unroll
              for (int ks = 0; ks < 2; ++ks) { v4u w; w.x = pkbf(xt[2 * ks][0], xt[2 * ks][1]); w.y = pkbf(xt[2 * ks][2], xt[2 * ks][3]); w.z = pkbf(xt[2 * ks + 1][0], xt[2 * ks + 1][1]); w.w = pkbf(xt[2 * ks + 1][2], xt[2 * ks + 1][3]); xf[ks] = __builtin_bit_cast(v8s, w); }
              v4f wx[2], rx[2], u[2];
#pragma unroll
              for (int m2 = 0; m2 < 2; ++m2) { wx[m2] = (v4f){0.f, 0.f, 0.f, 0.f}; rx[m2] = wx[m2];
#pragma unroll
                  for (int ks = 0; ks < 2; ++ks) { wx[m2] = mfma16(*(const LAS v8s*)(W2P + (16 * m2 + c16) * 72 + 32 * ks + 8 * q), xf[ks], wx[m2]); rx[m2] = mfma16(*(const LAS v8s*)(RTP + (16 * m2 + c16) * 72 + 32 * ks + 8 * q), xf[ks], rx[m2]); } }
              if (cs < 4) {
#pragma unroll
                  for (int m2 = 0; m2 < 2; ++m2) { v4f ol = {0.f, 0.f, 0.f, 0.f};
#pragma unroll
                      for (int ks = 0; ks < 2; ++ks) ol = mfma16(*(const LAS v8s*)(MRB + (16 * m2 + c16) * 72 + 32 * ks + 8 * q), *(const LAS v8s*)(VW + (16 * cs + c16) * 72 + 32 * ks + 8 * q), ol);
#pragma unroll
                      for (int r = 0; r < 4; ++r) { const int t = 16 * m2 + 4 * q + r; ol[r] += rx[m2][r]; u[m2][r] = -wx[m2][r] - W1F[t * 65 + 16 * cs + c16]; }
                      *(v4f*)(O0 + o0_frag(rowc + 16 * m2, h, cs) + (size_t)lane * 4) = ol; }
              } else {
#pragma unroll
                  for (int m2 = 0; m2 < 2; ++m2)
#pragma unroll
                      for (int r = 0; r < 4; ++r) { const int t = 16 * m2 + 4 * q + r; if (jb_.seg_slot >= 0) RHO[(size_t)(rowc + t) * AW + h * 64 + 16 * (cs - 4) + c16] = rx[m2][r]; u[m2][r] = -wx[m2][r]; }
              }
              v8s uf; { v4u w; w.x = pkbf(u[0][0], u[0][1]); w.y = pkbf(u[0][2], u[0][3]); w.z = pkbf(u[1][0], u[1][1]); w.w = pkbf(u[1][2], u[1][3]); uf = __builtin_bit_cast(v8s, w); }
#pragma unroll
              for (int jt = 0; jt < 4; ++jt) { const v4f eg4 = *(const LAS v4f*)(EG + 16 * jt + 4 * q); v4f acc = xt[jt] * eg4;
                  acc = mfma16(*(const LAS v8s*)(A2 + (16 * jt + c16) * 72 + 32 + 8 * q), uf, acc);
                  if (cs < 4) acc = mfma16(*(const LAS v8s*)(A2 + (16 * jt + c16) * 72 + 8 * q), *(const LAS v8s*)(VW + (16 * cs + c16) * 72 + 8 * q), acc);
                  xt[jt] = acc; } }
#endif
        }
    }
    if (FULL) {
        const int cs = wave;
        if (jb_.seg_slot >= 0) { float* dst = (float*)(ws + (cs < 4 ? OFF_SEGX : OFF_SEGP)) + (size_t)jb_.seg_slot * 4096 + 16 * (cs & 3) + c16;
#pragma unroll
            for (int jt = 0; jt < 4; ++jt)
#pragma unroll
                for (int r = 0; r < 4; ++r) dst[(16 * jt + 4 * q + r) * 64] = xt[jt][r];
        }
    }
}

template <bool FULL>
__device__ __forceinline__ void mixa_phase(const Args& a, int l, LAS unsigned char* lds, int vcu, int G, int tid) {
    for (int j = vcu; j < NBATCH * AH * NSEG; j += G) { const int b = j >> 6, h = (j >> 2) & 15, seg = j & 3; Job jb; jb.l = l;
        jb.row0 = b * SEQ + seg * SEGLEN; jb.nchunks = SEGCH; jb.nvalid = CH; jb.h = h; jb.prev0 = seg == 0 ? nullptr : (const float*)(a.ws + OFF_PA) + (size_t)(jb.row0 - 1) * APAD; jb.state_in = nullptr; jb.state_out = nullptr; jb.seg_slot = j;
        run_job<0>(a, jb, lds, tid); }
    for (int j = vcu; j < 16 * AH; j += G) { Job jb; jb.l = l; jb.row0 = j >> 4; jb.nchunks = 1; jb.nvalid = CH; jb.h = j & 15; jb.prev0 = nullptr; jb.state_in = nullptr; jb.state_out = nullptr; jb.seg_slot = -1;
        run_job<1>(a, jb, lds, tid); }
}

__device__ __forceinline__ void gn_tile(const Args& a, int l, int rowt, int h, v4f (&acc)[4], int q, int c16) {
    unsigned char* ws = a.ws; const bf16* GB = (const bf16*)(ws + OFF_GB); const bf16* BV = (const bf16*)(ws + OFF_BV); bf16* YA = (bf16*)(ws + OFF_YA);
    const float* lnw = INP(I_LNW) + l * AW + h * 64 + c16; const float* lnb = INP(I_LNB) + l * AW + h * 64 + c16;
#pragma unroll
    for (int r = 0; r < 4; ++r) { float s = (acc[0][r] + acc[1][r]) + (acc[2][r] + acc[3][r]);
        s += WS_DPP(s, 0xB1); s += WS_DPP(s, 0x4E); s += WS_DPP(s, 0x141); s += WS_DPP(s, 0x140);
        const float mean = s * (1.0f / 64.0f); float d[4], v = 0.f;
#pragma unroll
        for (int nt = 0; nt < 4; ++nt) { d[nt] = acc[nt][r] - mean; v += d[nt] * d[nt]; }
        v += WS_DPP(v, 0xB1); v += WS_DPP(v, 0x4E); v += WS_DPP(v, 0x141); v += WS_DPP(v, 0x140);
        const float rstd = 1.0f / sqrtf(v * (1.0f / 64.0f) + GN_EPS);
        const size_t ro = (size_t)(rowt + 4 * q + r) * AW + h * 64 + c16;
#pragma unroll
        for (int nt = 0; nt < 4; ++nt) { const float y = (d[nt] * rstd * lnw[16 * nt] + lnb[16 * nt] + bf2f(BV[ro + 16 * nt])) * bf2f(GB[ro + 16 * nt]); YA[ro + 16 * nt] = bf1(y); } }
}
__device__ __forceinline__ void mixb_phase(const Args& a, int l, LAS unsigned char* lds, int vcu, int G, int tid) {
    unsigned char* ws = a.ws; const float* O0 = (const float*)(ws + OFF_ORAW); const float* RHO = (const float*)(ws + OFF_RHO);
    const float* SEGX = (const float*)(ws + OFF_SEGX); const float* SEGP = (const float*)(ws + OFF_SEGP);
    const int lane = tid & 63, wave = __builtin_amdgcn_readfirstlane(tid >> 6), q = lane >> 4, c16 = lane & 15;
    LAS float* P = (LAS float*)lds;
    LAS float* Ya = (LAS float*)(lds + 16640);
    LAS float* Yb = (LAS float*)(lds + 16640 + 16384);
    LAS bf16* SB = (LAS bf16*)(lds + 16640 + 32768);
    const int mj = tid >> 3, mi = (tid & 7) * 8;
    for (int j = vcu; j < NBATCH * AH * NSEG; j += G) { const int b = j >> 6, h = (j >> 2) & 15, seg = j & 3; const int row0 = b * SEQ + seg * SEGLEN; const int j0 = j - seg;
        asm volatile("s_waitcnt lgkmcnt(0)\n\ts_barrier" ::: "memory");
        if (seg > 0) {
#pragma unroll
            for (int e = 0; e < 8; ++e) Ya[mj * 64 + mi + e] = SEGX[(size_t)j0 * 4096 + mj * 64 + mi + e];
            LAS float* cur = Ya; LAS float* nxt = Yb;
            const int nmul = (seg == 3) ? 3 : seg - 1;
            for (int s = 1; s <= nmul; ++s) {
                if (s == seg) {
                }
#pragma unroll
                for (int e = 0; e < 8; ++e) P[mj * 65 + mi + e] = SEGP[(size_t)(j0 + s) * 4096 + mj * 64 + mi + e];
                float acc[8];
#pragma unroll
                for (int e = 0; e < 8; ++e) acc[e] = SEGX[(size_t)(j0 + s) * 4096 + mj * 64 + mi + e];
                asm volatile("s_waitcnt lgkmcnt(0)\n\ts_barrier" ::: "memory");
                for (int m = 0; m < 64; ++m) { const float p = P[mj * 65 + m]; const v4f y0 = *(const LAS v4f*)(cur + m * 64 + mi), y1 = *(const LAS v4f*)(cur + m * 64 + mi + 4);
                    acc[0] += p * y0.x; acc[1] += p * y0.y; acc[2] += p * y0.z; acc[3] += p * y0.w; acc[4] += p * y1.x; acc[5] += p * y1.y; acc[6] += p * y1.z; acc[7] += p * y1.w; }
                if (s < seg) {
#pragma unroll
                    for (int e = 0; e < 8; ++e) nxt[mj * 64 + mi + e] = acc[e];
                    asm volatile("s_waitcnt lgkmcnt(0)\n\ts_barrier" ::: "memory");
                    LAS float* t_ = cur; cur = nxt; nxt = t_;
                } else {
                    float* dst = a.out + OUT_WKP + ((size_t)(l * NBATCH + b) * AH + h) * AN * AN;
#pragma unroll
                    for (int e = 0; e < 8; ++e) dst[(size_t)(mi + e) * 64 + mj] = acc[e];
                    asm volatile("s_waitcnt lgkmcnt(0)\n\ts_barrier" ::: "memory");
                }
            }
            asm volatile("s_waitcnt lgkmcnt(0)\n\ts_barrier" ::: "memory");
#pragma unroll
            for (int e = 0; e < 8; ++e) SB[(mi + e) * 72 + mj] = bf1(cur[mj * 64 + mi + e]);
            asm volatile("s_waitcnt lgkmcnt(0)\n\ts_barrier" ::: "memory");
        }
        for (int tt = wave; tt < SEGLEN / 16; tt += NWAVES) { const int rowt = row0 + 16 * tt; v4f acc[4];
#pragma unroll
            for (int nt = 0; nt < 4; ++nt) acc[nt] = *(const v4f*)(O0 + o0_frag(rowt, h, nt) + (size_t)lane * 4);
            if (seg > 0) { v8s af[2];
#pragma unroll
                for (int ks = 0; ks < 2; ++ks) { const float* rp = RHO + (size_t)(rowt + c16) * AW + h * 64 + 32 * ks + 8 * q; const v4f r0 = *(const v4f*)rp, r1 = *(const v4f*)(rp + 4);
                    v4u w; w.x = pkbf(r0.x, r0.y); w.y = pkbf(r0.z, r0.w); w.z = pkbf(r1.x, r1.y); w.w = pkbf(r1.z, r1.w); af[ks] = __builtin_bit_cast(v8s, w); }
#pragma unroll
                for (int nt = 0; nt < 4; ++nt)
#pragma unroll
                    for (int ks = 0; ks < 2; ++ks) acc[nt] = mfma16(af[ks], *(const LAS v8s*)(SB + (16 * nt + c16) * 72 + 32 * ks + 8 * q), acc[nt]); }
            gn_tile(a, l, rowt, h, acc, q, c16);
        }
    }
    for (int it = vcu * NWAVES + wave; it < (MS / 16) * AH; it += G * NWAVES) { const int tt = it >> 4, h = it & 15; const int rowt = MP + 16 * tt; v4f acc[4];
#pragma unroll
        for (int nt = 0; nt < 4; ++nt) acc[nt] = *(const v4f*)(O0 + o0_frag(rowt, h, nt) + (size_t)lane * 4);
        gn_tile(a, l, rowt, h, acc, q, c16);
    }
    asm volatile("s_waitcnt lgkmcnt(0)\n\ts_barrier" ::: "memory");
}

__device__ __forceinline__ void mini_branch(const Args& a, int l, int vcu, int G, int tid) {
    unsigned char* ws = a.ws; const bf16* YA = (const bf16*)(ws + OFF_YA); const bf16* YB = (const bf16*)(ws + OFF_YB); const bf16* WA = (const bf16*)(ws + OFF_WA + (size_t)l * SZ_WAB); const bf16* WB = (const bf16*)(ws + OFF_WB + (size_t)l * SZ_WAB);
    const bf16* Gt = (const bf16*)(ws + OFF_G); bf16* MRG = (bf16*)(ws + OFF_MRG);
    const int lane = tid & 63, wave = __builtin_amdgcn_readfirstlane(tid >> 6), q = lane >> 4, c16 = lane & 15;
    for (int tile = vcu; tile < (MS / 32) * (DM / 128); tile += G) { const int rg = tile >> 4, cg = tile & 15; const int row0 = MP + 32 * rg, colw = cg * 128 + 16 * wave;
        const bf16* pa0 = YA + (size_t)(row0 + c16) * AW + 8 * q; const bf16* pb0 = YB + (size_t)(row0 + c16) * AW + 8 * q;
        const bf16* pwa = WA + (size_t)(colw + c16) * AW + 8 * q; const bf16* pwb = WB + (size_t)(colw + c16) * AW + 8 * q;
        v4f acc[2][2];
#pragma unroll
        for (int p = 0; p < 2; ++p)
#pragma unroll
            for (int mt = 0; mt < 2; ++mt) acc[p][mt] = (v4f){0.f, 0.f, 0.f, 0.f};
#pragma unroll 2
        for (int k4 = 0; k4 < AW / 32; k4 += 4) { v8s fa[4][2], fb[4][2], wa[4], wb[4];
#pragma unroll
            for (int u = 0; u < 4; ++u) { const int ko = 32 * (k4 + u); fa[u][0] = *(const v8s*)(pa0 + ko); fa[u][1] = *(const v8s*)(pa0 + 16 * AW + ko); fb[u][0] = *(const v8s*)(pb0 + ko); fb[u][1] = *(const v8s*)(pb0 + 16 * AW + ko);
                wa[u] = *(const v8s*)(pwa + ko); wb[u] = *(const v8s*)(pwb + ko); }
#pragma unroll
            for (int u = 0; u < 4; ++u) { acc[0][0] = mfma16(fa[u][0], wa[u], acc[0][0]); acc[0][1] = mfma16(fa[u][1], wa[u], acc[0][1]); acc[1][0] = mfma16(fb[u][0], wb[u], acc[1][0]); acc[1][1] = mfma16(fb[u][1], wb[u], acc[1][1]); } }
#pragma unroll
        for (int mt = 0; mt < 2; ++mt)
#pragma unroll
            for (int r = 0; r < 4; ++r) { const size_t row = row0 + 16 * mt + 4 * q + r; const int col = colw + c16;
                const float ga = bf2f(Gt[row * (2 * DM) + col]), gb = bf2f(Gt[row * (2 * DM) + DM + col]); MRG[row * DM + col] = bf1(ga * acc[0][mt][r] + gb * acc[1][mt][r]); }
    }
}

__device__ __forceinline__ void mod_phase(const Args& a, LAS unsigned char* lds, int vcu, int G, int tid) {
    unsigned char* ws = a.ws; const bf16* AM = (const bf16*)(ws + OFF_AMOD); float* MOD = (float*)(ws + OFF_MOD); const float* WM = INP(I_WMOD); const float* BM_ = INP(I_BMOD);
    const int lane = tid & 63, wave = __builtin_amdgcn_readfirstlane(tid >> 6), q = lane >> 4, c16 = lane & 15;
    constexpr int SW = 144, WT_B = 32 * SW * 4, AT_B = 144 * 32 * 2, BUF_B = WT_B + AT_B, NRING = 5;
    static_assert(NRING * BUF_B <= LDSCTL_OFF && NMODC % SW == 0, "mod ring fits");
    for (int slab = vcu; slab < MODLD / SW; slab += G) { const int lyr = slab / (NMODC / SW), c0 = (slab - lyr * (NMODC / SW)) * SW;
        const float* wsrc = WM + (size_t)lyr * DM * NMODC + c0;
        v4f acc[9], acc2[9];
#pragma unroll
        for (int m = 0; m < 9; ++m) { acc[m] = (v4f){0.f, 0.f, 0.f, 0.f}; acc2[m] = acc[m]; }
#define MOD_STAGE(KB) do { const unsigned bo_ = (unsigned)((KB) % NRING) * BUF_B; \
        _Pragma("unroll") for (int i_ = 0; i_ < 3; ++i_) { int pi_ = wave * 3 + i_; pi_ = pi_ < 18 ? pi_ : pi_ - 18; const int p_ = 64 * pi_ + lane; const int row_ = p_ / 36, c4_ = p_ - row_ * 36; \
            __builtin_amdgcn_global_load_lds((const unsigned*)(wsrc + (size_t)(32 * (KB) + row_) * NMODC + 4 * c4_), (LAS unsigned*)(lds + bo_ + 1024 * pi_), 16, 0, 0); } \
        { const int pi_ = wave; const int row_ = 16 * pi_ + (lane >> 2); __builtin_amdgcn_global_load_lds((const unsigned*)(AM + (size_t)row_ * DM + 32 * (KB) + 8 * (lane & 3)), (LAS unsigned*)(lds + bo_ + WT_B + 1024 * pi_), 16, 0, 0); \
          const int row2_ = 128 + (lane >> 2); __builtin_amdgcn_global_load_lds((const unsigned*)(AM + (size_t)row2_ * DM + 32 * (KB) + 8 * (lane & 3)), (LAS unsigned*)(lds + bo_ + WT_B + 8192), 16, 0, 0); } } while (0)
        asm volatile("s_waitcnt lgkmcnt(0)\n\ts_barrier" ::: "memory");
#pragma unroll
        for (int kb = 0; kb < NRING - 1; ++kb) MOD_STAGE(kb);
        for (int kb = 0; kb < DM / 32; ++kb) {
            if (kb < DM / 32 - (NRING - 1)) asm volatile("s_waitcnt vmcnt(15)" ::: "memory"); else asm volatile("s_waitcnt vmcnt(0)" ::: "memory");
            asm volatile("s_waitcnt lgkmcnt(0)\n\ts_barrier" ::: "memory");
            if (kb + NRING - 1 < DM / 32) MOD_STAGE(kb + NRING - 1);
            const LAS float* WT = (const LAS float*)(lds + (unsigned)(kb % NRING) * BUF_B); const LAS bf16* AT = (const LAS bf16*)(lds + (unsigned)(kb % NRING) * BUF_B + WT_B);
            float w8[8];
#pragma unroll
            for (int j = 0; j < 8; ++j) w8[j] = WT[(8 * q + j) * SW + 16 * wave + c16];
            v4u wb; wb.x = pkbf(w8[0], w8[1]); wb.y = pkbf(w8[2], w8[3]); wb.z = pkbf(w8[4], w8[5]); wb.w = pkbf(w8[6], w8[7]); const v8s bfrag = __builtin_bit_cast(v8s, wb);
#pragma unroll
            for (int m = 0; m < 9; ++m) acc[m] = mfma16(*(const LAS v8s*)(AT + (16 * m + c16) * 32 + 8 * q), bfrag, acc[m]);
            if (wave == 0) {
#pragma unroll
                for (int j = 0; j < 8; ++j) w8[j] = WT[(8 * q + j) * SW + 128 + c16];
                wb.x = pkbf(w8[0], w8[1]); wb.y = pkbf(w8[2], w8[3]); wb.z = pkbf(w8[4], w8[5]); wb.w = pkbf(w8[6], w8[7]); const v8s bfrag2 = __builtin_bit_cast(v8s, wb);
#pragma unroll
                for (int m = 0; m < 9; ++m) acc2[m] = mfma16(*(const LAS v8s*)(AT + (16 * m + c16) * 32 + 8 * q), bfrag2, acc2[m]); }
        }
#undef MOD_STAGE
        { const int gcol = lyr * NMODC + c0 + 16 * wave + c16; const float bias = BM_[gcol];
#pragma unroll
          for (int m = 0; m < 9; ++m)
#pragma unroll
              for (int r = 0; r < 4; ++r) { const int row = 16 * m + 4 * q + r; if (row < NSEQ) MOD[(size_t)row * MODLD + gcol] = acc[m][r] + bias; } }
        if (wave == 0) { const int gcol = lyr * NMODC + c0 + 128 + c16; const float bias = BM_[gcol];
#pragma unroll
          for (int m = 0; m < 9; ++m)
#pragma unroll
              for (int r = 0; r < 4; ++r) { const int row = 16 * m + 4 * q + r; if (row < NSEQ) MOD[(size_t)row * MODLD + gcol] = acc2[m][r] + bias; } }
    }
    asm volatile("s_waitcnt vmcnt(0) lgkmcnt(0)\n\ts_barrier" ::: "memory");
}
#undef MIX_PREFETCH_DMA
#undef MIX_ROW
#undef MIX_BAR
}

#ifndef SITE_MASK
#define SITE_MASK 0xffffffffu
#endif
#define SITE_EN(i) (((SITE_MASK) >> (i)) & 1u)
#ifndef REP_MASK
#define REP_MASK 0u
#endif
#ifndef REP_N
#define REP_N 2
#endif
#define SITE_REPS(i) ((((REP_MASK) >> (i)) & 1u) ? (REP_N) : 1)
constexpr int CW_BAR = 4096;
constexpr int N_PHASES = 2 + 12 * DEPTH + 1;
__global__ void __launch_bounds__(NWAVES * 64, 2) fwd(Args a) {
    extern __shared__ __attribute__((aligned(16))) unsigned char lds_raw[];
    LAS unsigned char* lds0 = (LAS unsigned char*)lds_raw;
    const int tid = threadIdx.x; const int wave0 = __builtin_amdgcn_readfirstlane(tid >> 6);
    const int G = gridDim.x; const int bx = blockIdx.x; const int vcu = (G % 8 == 0) ? (bx % 8) * (G / 8) + bx / 8 : bx;
    unsigned char* ws0 = a.ws;
    for (int u = tid; u < (LDS_BYTES - LDSCTL_OFF) / 4; u += NWAVES * 64) ((LAS unsigned*)(lds0 + LDSCTL_OFF))[u] = 0u;
    __syncthreads();
    if (tid < N_IN) ((LAS unsigned long long*)(lds0 + PTAB_OFF))[tid] = (unsigned long long)a.in[tid];
    __syncthreads();
    XcdBarrier bar; bar.bar = (unsigned*)(ws0 + OFF_CTL) + CW_BAR; bar.x = 0; bar.st = nullptr;
    if (a.use_bar) bar = xcd_barrier_post((unsigned*)(ws0 + OFF_CTL) + CW_BAR, (volatile LAS unsigned*)(lds0 + MISC_OFF) + 8);
    if (a.use_bar) xcd_barrier_census(bar);
    const int lo = a.ph_lo, hi = a.ph_hi; int ph = 0;
#define PH_ON (ph >= lo && ph < hi)
#define SITE_IDS int wave = wave0; asm volatile("" : "+s"(wave)); const int lane = (int)__builtin_amdgcn_mbcnt_hi(~0u, __builtin_amdgcn_mbcnt_lo(~0u, 0u)); int tid_ = wave * 64 + lane; asm volatile("" : "+v"(tid_)); const int gw = vcu * NWAVES + wave, NGW = G * NWAVES; (void)lane; (void)gw; (void)NGW; \
        LAS unsigned char* lds = lds0; asm volatile("" : "+s"(lds));   GAS unsigned char* wsg_ = (GAS unsigned char*)ws0; asm volatile("" : "+s"(wsg_)); unsigned char* ws = (unsigned char*)wsg_; int l = l0; asm volatile("" : "+s"(l));   \
        GAS float* outg_ = (GAS float*)a.out; asm volatile("" : "+s"(outg_)); float* outl = (float*)outg_; Args al; al.ws = ws; al.out = outl;   \
        float* X = (float*)(ws + OFF_X); bf16* H = (bf16*)(ws + OFF_H); const float* MOD = (const float*)(ws + OFF_MOD); const int mb = l * NMODC; const float* ng = INP(I_NG) + (size_t)l * 3 * DM; (void)X; (void)H; (void)MOD; (void)mb; (void)ng;
#define PH_END do { if (PH_ON && ph + 1 < hi) xcd_barrier(bar); ++ph; } while (0)
#define GEMM(EpiT, Ap, Bp, Mv, Nv, Kv, ...) do { pg8::Gemm g_{(const pg8::bf16_t*)(Ap), (const pg8::bf16_t*)(Bp), (Mv), (Nv), (Kv), nullptr, nullptr}; pg8::StaticOrder S_; S_.init((Mv), (Nv), G, bx); \
        pg8::EpiT E_{__VA_ARGS__}; pg8::gemm_phase<pg8::EpiT, pg8::StaticOrder, true, true>(lds + RING_OFF, g_, S_, E_, tid_); } while (0)
#define GEMM_SPLIT(EpiT, Ap, Bp, Nv, Kv, PIECES, PKT, ...) do { pg8::Gemm g_{(const pg8::bf16_t*)(Ap), (const pg8::bf16_t*)(Bp), MT, (Nv), (Kv), nullptr, nullptr}; pg8::SplitOrder S_; S_.init(MP, MS, (Nv), (Kv), G, bx, (PIECES), (PKT)); \
        pg8::EpiT E_{__VA_ARGS__}; pg8::gemm_phase<pg8::EpiT, pg8::SplitOrder, true, true>(lds + RING_OFF, g_, S_, E_, tid_); } while (0)
    int l0 = 0;

    { if (PH_ON && SITE_EN(0)) { constexpr int rep_ = 0; SITE_IDS p0_phase(al, lds, vcu, G, wave, lane); } if (SITE_REPS(0) > 1) { if (PH_ON) xcd_barrier(bar); if (PH_ON && SITE_EN(0)) { constexpr int rep_ = 1; SITE_IDS p0_phase(al, lds, vcu, G, wave, lane); } } }
    PH_END;
    { if (PH_ON && SITE_EN(1)) { constexpr int rep_ = 0; SITE_IDS mix::mod_phase(al, lds, vcu, G, tid_); } if (SITE_REPS(1) > 1) { if (PH_ON) xcd_barrier(bar); if (PH_ON && SITE_EN(1)) { constexpr int rep_ = 1; SITE_IDS mix::mod_phase(al, lds, vcu, G, tid_); } } }
    PH_END;

    for (l0 = 0; l0 < DEPTH; ++l0) {
        { if (PH_ON && SITE_EN(2)) { constexpr int rep_ = 0; SITE_IDS norm_phase(X, ng, MOD, mb + 0 * DM, mb + 1 * DM, H, gw, NGW, lane, (const float*)(ws + OFF_PART), (l > 0 && rep_ == 0) ? 15 : 0, l == 0 ? INP(I_XP) : nullptr, l == 0 ? INP(I_XS) : nullptr); } if (SITE_REPS(2) > 1) { if (PH_ON) xcd_barrier(bar); if (PH_ON && SITE_EN(2)) { constexpr int rep_ = 1; SITE_IDS norm_phase(X, ng, MOD, mb + 0 * DM, mb + 1 * DM, H, gw, NGW, lane, (const float*)(ws + OFF_PART), (l > 0 && rep_ == 0) ? 15 : 0, l == 0 ? INP(I_XP) : nullptr, l == 0 ? INP(I_XS) : nullptr); } } }
        PH_END;
        { if (PH_ON && SITE_EN(3)) { constexpr int rep_ = 0; SITE_IDS GEMM(EpiSwiGLU, H, ws + OFF_WGU + (size_t)(l * 2 + 0) * SZ_WGU, MT, 2 * DFF, DM, (pg8::bf16_t*)(ws + OFF_R1), DFF); } if (SITE_REPS(3) > 1) { if (PH_ON) xcd_barrier(bar); if (PH_ON && SITE_EN(3)) { constexpr int rep_ = 1; SITE_IDS GEMM(EpiSwiGLU, H, ws + OFF_WGU + (size_t)(l * 2 + 0) * SZ_WGU, MT, 2 * DFF, DM, (pg8::bf16_t*)(ws + OFF_R1), DFF); } } }
        PH_END;
        { if (PH_ON && SITE_EN(4)) { constexpr int rep_ = 0; SITE_IDS GEMM_SPLIT(EpiResid, ws + OFF_R1, ws + OFF_WD + (size_t)(l * 2 + 0) * SZ_WD, DM, DFF, 15, 6, X, MOD, mb + 2 * DM, rep_ == 0 ? 0.5f : 0.f, (l == 0 && rep_ == 0) ? INP(I_XP) : (const float*)X); } if (SITE_REPS(4) > 1) { if (PH_ON) xcd_barrier(bar); if (PH_ON && SITE_EN(4)) { constexpr int rep_ = 1; SITE_IDS GEMM_SPLIT(EpiResid, ws + OFF_R1, ws + OFF_WD + (size_t)(l * 2 + 0) * SZ_WD, DM, DFF, 15, 6, X, MOD, mb + 2 * DM, rep_ == 0 ? 0.5f : 0.f, (l == 0 && rep_ == 0) ? INP(I_XP) : (const float*)X); } } }
        PH_END;
        { if (PH_ON && SITE_EN(5)) { constexpr int rep_ = 0; SITE_IDS norm_phase(X, ng + DM, MOD, mb + 3 * DM, mb + 4 * DM, H, gw, NGW, lane, (const float*)(ws + OFF_PART), rep_ == 0 ? 15 : 0, nullptr, (l == 0 && rep_ == 0) ? INP(I_XS) : nullptr); } if (SITE_REPS(5) > 1) { if (PH_ON) xcd_barrier(bar); if (PH_ON && SITE_EN(5)) { constexpr int rep_ = 1; SITE_IDS norm_phase(X, ng + DM, MOD, mb + 3 * DM, mb + 4 * DM, H, gw, NGW, lane, (const float*)(ws + OFF_PART), rep_ == 0 ? 15 : 0, nullptr, (l == 0 && rep_ == 0) ? INP(I_XS) : nullptr); } } }
        PH_END;
        { if (PH_ON && SITE_EN(6)) { constexpr int rep_ = 0; SITE_IDS GEMM(EpiInProj, H, ws + OFF_WIN + (size_t)l * SZ_WIN, MT, NIN, DM, (float*)(ws + OFF_PA), (pg8::bf16_t*)(ws + OFF_PB), (pg8::bf16_t*)(ws + OFF_G)); } if (SITE_REPS(6) > 1) { if (PH_ON) xcd_barrier(bar); if (PH_ON && SITE_EN(6)) { constexpr int rep_ = 1; SITE_IDS GEMM(EpiInProj, H, ws + OFF_WIN + (size_t)l * SZ_WIN, MT, NIN, DM, (float*)(ws + OFF_PA), (pg8::bf16_t*)(ws + OFF_PB), (pg8::bf16_t*)(ws + OFF_G)); } } }
        PH_END;
        { if (PH_ON && SITE_EN(9)) { constexpr int rep_ = 0; { SITE_IDS mix::mixa_phase<true>(al, l, lds, vcu, G, tid_); } { SITE_IDS e1_phase(al, l, gw, NGW, lane, rep_ == 0); } } if (SITE_REPS(9) > 1) { if (PH_ON) xcd_barrier(bar); if (PH_ON && SITE_EN(9)) { constexpr int rep_ = 1; { SITE_IDS mix::mixa_phase<true>(al, l, lds, vcu, G, tid_); } { SITE_IDS e1_phase(al, l, gw, NGW, lane, rep_ == 0); } } } }
        PH_END;
        { if (PH_ON && SITE_EN(11)) { constexpr int rep_ = 0; { SITE_IDS mix::mixb_phase(al, l, lds, vcu, G, tid_); } { SITE_IDS attn_phase(al, l, lds, gw, NGW, wave, lane); } } if (SITE_REPS(11) > 1) { if (PH_ON) xcd_barrier(bar); if (PH_ON && SITE_EN(11)) { constexpr int rep_ = 1; { SITE_IDS mix::mixb_phase(al, l, lds, vcu, G, tid_); } { SITE_IDS attn_phase(al, l, lds, gw, NGW, wave, lane); } } } }
        PH_END;
        { if (PH_ON && SITE_EN(12)) { constexpr int rep_ = 0; SITE_IDS { pg8::Gemm g_{(const pg8::bf16_t*)(ws + OFF_YA), (const pg8::bf16_t*)(ws + OFF_WA + (size_t)l * SZ_WAB), MT, DM, AW, (const pg8::bf16_t*)(ws + OFF_YB), (const pg8::bf16_t*)(ws + OFF_WB + (size_t)l * SZ_WAB)}; pg8::PairOrder S_; S_.init(MP, DM, G, bx); pg8::EpiBranch E_{(float*)(ws + OFF_MA), (const pg8::bf16_t*)(ws + OFF_G), (pg8::bf16_t*)(ws + OFF_MRG)}; pg8::gemm_phase<pg8::EpiBranch, pg8::PairOrder, true, true>(lds + RING_OFF, g_, S_, E_, tid_); } mix::mini_branch(al, l, vcu, G, tid_); } if (SITE_REPS(12) > 1) { if (PH_ON) xcd_barrier(bar); if (PH_ON && SITE_EN(12)) { constexpr int rep_ = 1; SITE_IDS { pg8::Gemm g_{(const pg8::bf16_t*)(ws + OFF_YA), (const pg8::bf16_t*)(ws + OFF_WA + (size_t)l * SZ_WAB), MT, DM, AW, (const pg8::bf16_t*)(ws + OFF_YB), (const pg8::bf16_t*)(ws + OFF_WB + (size_t)l * SZ_WAB)}; pg8::PairOrder S_; S_.init(MP, DM, G, bx); pg8::EpiBranch E_{(float*)(ws + OFF_MA), (const pg8::bf16_t*)(ws + OFF_G), (pg8::bf16_t*)(ws + OFF_MRG)}; pg8::gemm_phase<pg8::EpiBranch, pg8::PairOrder, true, true>(lds + RING_OFF, g_, S_, E_, tid_); } mix::mini_branch(al, l, vcu, G, tid_); } } }
        PH_END;
        { if (PH_ON && SITE_EN(14)) { constexpr int rep_ = 0; SITE_IDS GEMM_SPLIT(EpiResid, ws + OFF_MRG, ws + OFF_WOUT + (size_t)l * SZ_WOUT, DM, DM, 8, 4, X, MOD, mb + 5 * DM, rep_ == 0 ? 1.0f : 0.f, (const float*)X); } if (SITE_REPS(14) > 1) { if (PH_ON) xcd_barrier(bar); if (PH_ON && SITE_EN(14)) { constexpr int rep_ = 1; SITE_IDS GEMM_SPLIT(EpiResid, ws + OFF_MRG, ws + OFF_WOUT + (size_t)l * SZ_WOUT, DM, DM, 8, 4, X, MOD, mb + 5 * DM, rep_ == 0 ? 1.0f : 0.f, (const float*)X); } } }
        PH_END;
        { if (PH_ON && SITE_EN(15)) { constexpr int rep_ = 0; SITE_IDS norm_phase(X, ng + 2 * DM, MOD, mb + 6 * DM, mb + 7 * DM, H, gw, NGW, lane, (const float*)(ws + OFF_PART), rep_ == 0 ? 8 : 0, nullptr, nullptr); } if (SITE_REPS(15) > 1) { if (PH_ON) xcd_barrier(bar); if (PH_ON && SITE_EN(15)) { constexpr int rep_ = 1; SITE_IDS norm_phase(X, ng + 2 * DM, MOD, mb + 6 * DM, mb + 7 * DM, H, gw, NGW, lane, (const float*)(ws + OFF_PART), rep_ == 0 ? 8 : 0, nullptr, nullptr); } } }
        PH_END;
        { if (PH_ON && SITE_EN(16)) { constexpr int rep_ = 0; SITE_IDS GEMM(EpiSwiGLU, H, ws + OFF_WGU + (size_t)(l * 2 + 1) * SZ_WGU, MT, 2 * DFF, DM, (pg8::bf16_t*)(ws + OFF_R1), DFF); } if (SITE_REPS(16) > 1) { if (PH_ON) xcd_barrier(bar); if (PH_ON && SITE_EN(16)) { constexpr int rep_ = 1; SITE_IDS GEMM(EpiSwiGLU, H, ws + OFF_WGU + (size_t)(l * 2 + 1) * SZ_WGU, MT, 2 * DFF, DM, (pg8::bf16_t*)(ws + OFF_R1), DFF); } } }
        PH_END;
        { if (PH_ON && SITE_EN(17)) { constexpr int rep_ = 0; SITE_IDS GEMM_SPLIT(EpiResid, ws + OFF_R1, ws + OFF_WD + (size_t)(l * 2 + 1) * SZ_WD, DM, DFF, 15, 6, X, MOD, mb + 8 * DM, rep_ == 0 ? 0.5f : 0.f, (const float*)X); } if (SITE_REPS(17) > 1) { if (PH_ON) xcd_barrier(bar); if (PH_ON && SITE_EN(17)) { constexpr int rep_ = 1; SITE_IDS GEMM_SPLIT(EpiResid, ws + OFF_R1, ws + OFF_WD + (size_t)(l * 2 + 1) * SZ_WD, DM, DFF, 15, 6, X, MOD, mb + 8 * DM, rep_ == 0 ? 0.5f : 0.f, (const float*)X); } } }
        PH_END;
    }
#ifdef DUMP_OFF
    if (PH_ON) { SITE_IDS const size_t n = (size_t)DUMP_ELEMS; for (size_t i = (size_t)gw * 64 + lane; i < n; i += (size_t)NGW * 64) a.out[i] = DUMP_BF16 ? bf2f(((const bf16*)(ws + DUMP_OFF))[i]) : ((const float*)(ws + DUMP_OFF))[i]; }
#else
    if (PH_ON && SITE_EN(18)) { SITE_IDS final_norm_phase(X, INP(I_FN), outl + OUT_Y, gw, NGW, lane, (const float*)(ws + OFF_PART), 15); }
#endif
    PH_END;
#undef PH_ON
#undef PH_END
#undef GEMM
#undef GEMM_SPLIT
}

#ifndef MK_PER_PHASE
#define MK_PER_PHASE 0
#endif
extern "C" void kernel_launch(void* const* d_in, const int* in_sizes, int n_in, void* d_out, int out_size, void* d_ws, size_t ws_size, hipStream_t stream) {
    static int grid = 0;
    if (grid == 0) {
        if (n_in != N_IN || out_size != (int)OUT_END || ws_size < WS_END) { fprintf(stderr, "kernel_launch: shape mismatch: n_in %d out %d ws %zu (need %zu)\n", n_in, out_size, ws_size, (size_t)WS_END); grid = -1; return; }
        int dev = 0, cus = 0, per_cu = 0;
        if (hipGetDevice(&dev) != hipSuccess || hipDeviceGetAttribute(&cus, hipDeviceAttributeMultiprocessorCount, dev) != hipSuccess) { grid = -1; return; }
        if (hipFuncSetAttribute((const void*)fwd, hipFuncAttributeMaxDynamicSharedMemorySize, LDS_BYTES) != hipSuccess) { fprintf(stderr, "kernel_launch: hipFuncSetAttribute failed\n"); grid = -1; return; }
        if (hipOccupancyMaxActiveBlocksPerMultiprocessor(&per_cu, (const void*)fwd, NWAVES * 64, LDS_BYTES) != hipSuccess || per_cu < 1) fprintf(stderr, "kernel_launch: occupancy query reports %d\n", per_cu);
        (void)hipGetLastError();
        grid = cus;
    }
    if (grid < 0) return;
    (void)hipMemsetAsync((char*)d_ws + OFF_CTL, 0, (size_t)(CW_BAR + XCD_BAR_WORDS) * 4, stream);
    Args a{};
    for (int i = 0; i < N_IN; ++i) a.in[i] = (const float*)d_in[i];
    a.out = (float*)d_out; a.ws = (unsigned char*)d_ws; a.pad = 0;
#if MK_PER_PHASE
#ifndef LAST_PHASE
#define LAST_PHASE (N_PHASES - 2)
#endif
    for (int p = 0; p < N_PHASES; ++p) { if (p > LAST_PHASE && p != N_PHASES - 1) continue; a.ph_lo = p; a.ph_hi = p + 1; a.use_bar = 0;
        hipLaunchKernelGGL(fwd, dim3(grid), dim3(NWAVES * 64), LDS_BYTES, stream, a); }
#else
    a.ph_lo = 0; a.ph_hi = N_PHASES; a.use_bar = 1;
    hipLaunchKernelGGL(fwd, dim3(grid), dim3(NWAVES * 64), LDS_BYTES, stream, a);
#endif
    const hipError_t le = hipPeekAtLastError();
    if (le != hipSuccess) fprintf(stderr, "kernel_launch: launch failed: %s\n", hipGetErrorName(le));
}
```

```cpp
#include <hip/hip_runtime.h>
#include <cstdio>
#include <cstdint>
#include <cmath>

constexpr int DM = 2048, NBATCH = 4, SEQ = 2048, DEPTH = 2, DBATCH = 128, DSEQ = 4, PAST = 8192;
constexpr int MP = NBATCH * SEQ;
constexpr int MS = DBATCH * DSEQ;
constexpr int MT = MP + MS;
constexpr int NSEQ = NBATCH + DBATCH;
constexpr int AW = 1024, AH = 16, AN = 64, APROJ = 3360, APAD = 3584, QW = 1024, KVW = 256, BPROJ = 1536, WIN = 128, DFF = 5632;
constexpr int NIN = APAD + BPROJ + 2 * DM;
constexpr int NMODC = 9 * DM;
constexpr int MODLD = DEPTH * NMODC;
constexpr int LK = 384, LN3 = 3072;
constexpr float RMS_EPS = 1e-6f, GN_EPS = 64e-5f;

__host__ __device__ __forceinline__ int seq_of_row(int r) { return r < MP ? (r >> 11) : NBATCH + ((r - MP) >> 2); }

constexpr size_t MiB = 1u << 20;
constexpr size_t OFF_CTL = 0, CTL_BYTES = 1 * MiB;
constexpr size_t OFF_WGU = 1 * MiB,   SZ_WGU = (size_t)2 * DFF * DM * 2;
constexpr size_t OFF_WD = OFF_WGU + 4 * SZ_WGU, SZ_WD = (size_t)DM * DFF * 2;
constexpr size_t OFF_WIN = OFF_WD + 4 * SZ_WD, SZ_WIN = (size_t)NIN * DM * 2;
constexpr size_t OFF_WA = OFF_WIN + 2 * SZ_WIN, SZ_WAB = (size_t)DM * AW * 2;
constexpr size_t OFF_WB = OFF_WA + 2 * SZ_WAB;
constexpr size_t OFF_WOUT = OFF_WB + 2 * SZ_WAB, SZ_WOUT = (size_t)DM * DM * 2;
constexpr size_t OFF_WL = OFF_WOUT + 2 * SZ_WOUT, SZ_WL = (size_t)LN3 * LK * 2;
constexpr size_t OFF_AMOD = OFF_WL + 2 * SZ_WL + MiB / 2;
constexpr size_t OFF_MOD = OFF_AMOD + 1 * MiB;
constexpr size_t OFF_X = OFF_MOD + (size_t)256 * MODLD * 4;
constexpr size_t OFF_H = OFF_X + (size_t)MT * DM * 4;
constexpr size_t OFF_R1 = OFF_H + (size_t)MT * DM * 2;
constexpr size_t SZ_R1 = (size_t)MT * 16 * 384 * 4;
constexpr size_t OFF_RHO = OFF_R1;
constexpr size_t OFF_GB = OFF_RHO + (size_t)MT * AW * 4;
constexpr size_t OFF_BV = OFF_GB + (size_t)MT * AW * 2;
constexpr size_t OFF_SEGX = OFF_BV + (size_t)MT * AW * 2;
constexpr size_t OFF_SEGP = OFF_SEGX + (size_t)256 * 4096 * 4;
constexpr size_t OFF_PART = OFF_R1 + 100 * MiB;
static_assert(OFF_SEGP + (size_t)256 * 4096 * 4 <= OFF_PART && (size_t)MT * DFF * 2 <= 100 * MiB && OFF_PART + (size_t)15 * MS * DM * 4 <= OFF_R1 + SZ_R1, "mixer scratch / PART inside R1");
constexpr size_t OFF_PA = OFF_R1 + SZ_R1;
constexpr size_t OFF_MA = OFF_PA, OFF_MRG = OFF_PA + (size_t)MT * DM * 4;
constexpr size_t OFF_PB = OFF_PA + (size_t)MT * APAD * 4;
constexpr size_t OFF_G = OFF_PB + (size_t)MT * BPROJ * 2;
constexpr size_t OFF_LIN = OFF_G + (size_t)MT * 2 * DM * 2;
constexpr size_t OFF_RK = OFF_LIN + (size_t)MT * LK * 2;
constexpr size_t OFF_YA = OFF_RK + (size_t)MT * 16 * 4;
constexpr size_t OFF_YB = OFF_YA + (size_t)MT * AW * 2;
constexpr size_t OFF_WMOD = OFF_YB + (size_t)MT * AW * 2;
constexpr size_t OFF_LOUT = OFF_WMOD, OFF_ORAW = OFF_WMOD + (size_t)MT * LN3 * 4;
constexpr size_t WS_END = OFF_WMOD + (size_t)MODLD * DM * 2;
static_assert(OFF_MRG + (size_t)MT * DM * 2 <= OFF_PB, "MA|MRG overlay PA");
static_assert(OFF_ORAW + (size_t)MT * AW * 4 <= WS_END, "LOUT|ORAW overlay WMOD");
static_assert((size_t)MT * DFF * 2 <= SZ_R1, "T fits R1");
static_assert(OFF_WGU % 256 == 0 && OFF_WD % 256 == 0 && OFF_WIN % 256 == 0 && OFF_WL % 256 == 0 && OFF_AMOD % 256 == 0 && OFF_MOD % 256 == 0 && OFF_X % 256 == 0 && OFF_H % 256 == 0 && OFF_R1 % 256 == 0 &&
              OFF_PA % 256 == 0 && OFF_PB % 256 == 0 && OFF_G % 256 == 0 && OFF_LIN % 256 == 0 && OFF_RK % 256 == 0 && OFF_YA % 256 == 0 && OFF_YB % 256 == 0 && OFF_WMOD % 256 == 0 && OFF_ORAW % 256 == 0 && OFF_MRG % 256 == 0, "alignment");

constexpr size_t OUT_Y = 0;
constexpr size_t OUT_SHP = (size_t)MT * DM;
constexpr size_t OUT_WKP = OUT_SHP + (size_t)DEPTH * NBATCH * APROJ;
constexpr size_t OUT_KP = OUT_WKP + (size_t)DEPTH * NBATCH * AH * AN * AN;
constexpr size_t OUT_VP = OUT_KP + (size_t)DEPTH * NBATCH * WIN * KVW;
constexpr size_t OUT_SHS = OUT_VP + (size_t)DEPTH * NBATCH * WIN * KVW;
constexpr size_t OUT_WKS = OUT_SHS + (size_t)DEPTH * DBATCH * APROJ;
constexpr size_t OUT_KS = OUT_WKS + (size_t)DEPTH * DBATCH * AH * AN * AN;
constexpr size_t OUT_VS = OUT_KS + (size_t)DEPTH * DBATCH * WIN * KVW;
constexpr size_t OUT_END = OUT_VS + (size_t)DEPTH * DBATCH * WIN * KVW;
static_assert(OUT_END == 53315840, "output size");

enum { I_XP = 0, I_XS, I_CP, I_CS, I_SSH, I_SWKV, I_CK, I_CV, I_NG, I_WMOD, I_BMOD, I_FG, I_FU, I_FD, I_WIN, I_MU, I_W0, I_W2, I_A0, I_A2, I_G2, I_KK, I_KA, I_RK, I_LNW, I_LNB, I_SINK, I_WA, I_WB, I_WMG, I_WOUT, I_FN, N_IN };

typedef unsigned short bf16;
#define GAS __attribute__((address_space(1)))
#define LAS __attribute__((address_space(3)))
typedef unsigned v4u __attribute__((ext_vector_type(4)));
typedef unsigned v2u __attribute__((ext_vector_type(2)));
typedef float v4f __attribute__((ext_vector_type(4)));
typedef float v16f __attribute__((ext_vector_type(16)));
typedef short v8s __attribute__((ext_vector_type(8)));
__device__ __forceinline__ unsigned f2bf(float f) { unsigned u = __builtin_bit_cast(unsigned, f); return (u + 0x7fffu + ((u >> 16) & 1u)) >> 16; }
__device__ __forceinline__ unsigned pk2(float lo, float hi) { return f2bf(lo) | (f2bf(hi) << 16); }
__device__ __forceinline__ float bf2f(unsigned h) { return __uint_as_float(h << 16); }
__device__ __forceinline__ float bflo(unsigned w) { return __uint_as_float(w << 16); }
__device__ __forceinline__ float bfhi(unsigned w) { return __uint_as_float(w & 0xffff0000u); }
__device__ __forceinline__ float sigmoidf_(float x) { return 1.0f / (1.0f + __expf(-x)); }
__device__ __forceinline__ float siluf_(float x) { return x / (1.0f + __expf(-x)); }
namespace pg8 {
#define PG8_LAS __attribute__((address_space(3)))
typedef unsigned short bf16_t;
typedef short bf16x8 __attribute__((ext_vector_type(8)));
typedef float f32x4 __attribute__((ext_vector_type(4)));
typedef unsigned u32x4 __attribute__((ext_vector_type(4)));
constexpr int BM = 256, BK = 64, HALF = 128, HTB = HALF * BK * 2  , STAGE_BYTES = 8 * HTB, NXCD = 8, WGM = 8;

__host__ __device__ __forceinline__ int lds_byte(int r, int c) { const int st = (r >> 4) * 2 + (c >> 5), rr = r & 15, cc = c & 31, ob = rr * 64 + cc * 2; return st * 1024 + (ob ^ (((ob >> 9) & 1) << 5)); }
__host__ __device__ __forceinline__ void stage_rc(int b, int& R, int& C) { const int st = b / 1024, sb = b % 1024, swz = sb ^ (((sb >> 9) & 1) << 5); R = (st >> 1) * 16 + swz / 64; C = (st & 1) * 32 + (swz % 64) / 2; }
__host__ __device__ __forceinline__ int perm32(int rho) { const int n = rho >> 4, i = rho & 15; return 8 * (i >> 2) + 4 * n + (i & 3); }

struct Unit { int pm, pn; };     __host__ __device__ __forceinline__ int un_kt0(const Unit& u) { return (u.pn >> 8) & 0xfff; } __host__ __device__ __forceinline__ int un_nkt(const Unit& u) { return (u.pn >> 20) & 0xff; } __host__ __device__ __forceinline__ int un_slice(const Unit& u) { return (u.pn >> 28) & 0xf; }
struct Gemm { const bf16_t* A; const bf16_t* Bt; int M, N, K; const bf16_t* A2; const bf16_t* Bt2; };

struct StaticOrder {
    int nM, nN, nwg, G, c;
    __host__ __device__ __forceinline__ void init(int M, int N, int G_, int c_) { nM = M / BM; nN = N / BM; nwg = nM * nN; G = G_; c = c_; }
    __host__ __device__ __forceinline__ bool next(int i, Unit& u) const {
        const long L = (long)i * G + c; if (L >= nwg) return false;
        int wgid = (int)L; { const int q = nwg / NXCD, r = nwg % NXCD, xcd = wgid % NXCD, off = wgid / NXCD; wgid = (xcd < r ? xcd * (q + 1) : r * (q + 1) + (xcd - r) * q) + off; }
        const int nig = WGM * nN, gid = wgid / nig, fm = gid * WGM, gsz = (nM - fm) < WGM ? (nM - fm) : WGM;
        u.pm = fm + ((wgid % nig) % gsz); u.pn = (wgid % nig) / gsz; return true;
    }
    __device__ __forceinline__ void a_ready(const Unit&) const {}
    __device__ __forceinline__ void done(const Unit&) const {}
};
struct SplitOrder {
    StaticOrder so; int c, ntile, pieces, pk, nkt_all, pm0;
    __host__ __device__ __forceinline__ void init(int Mfull, int Mrest, int N, int K, int G_, int c_, int pieces_, int pk_) { so.init(Mfull, N, G_, c_); c = c_; ntile = (Mrest / BM) * (N / BM); pieces = pieces_; pk = pk_; nkt_all = K / BK; pm0 = Mfull / BM; }
    __host__ __device__ __forceinline__ bool next(int i, Unit& u) const {
        if (i == 0) return so.next(0, u);
        if (i == 1 && c < ntile * pieces) { const int tile = c / pieces, sl = c - tile * pieces; const int nN = so.nN;
            const int kt0 = sl * pk, rem = nkt_all - kt0, nkt = rem < pk ? rem : pk; u.pm = pm0 + tile / nN; u.pn = (tile % nN) | (kt0 << 8) | (nkt << 20) | (sl << 28); return true; }
        return false;
    }
    __device__ __forceinline__ void a_ready(const Unit&) const {}
    __device__ __forceinline__ void done(const Unit&) const {}
};
struct PairOrder {
    StaticOrder so;
    __host__ __device__ __forceinline__ void init(int Mfull, int N, int G_, int c_) { so.init(Mfull, N, G_, c_); }
    __host__ __device__ __forceinline__ bool next(int i, Unit& u) const { if (i > 1) return false; const bool ok = so.next(0, u); u.pm |= (i << 8); return ok; }
    __device__ __forceinline__ void a_ready(const Unit&) const {}
    __device__ __forceinline__ void done(const Unit&) const {}
};

typedef float f32x2_t __attribute__((ext_vector_type(2))); typedef __bf16 bf16x2_t __attribute__((ext_vector_type(2)));
__device__ __forceinline__ unsigned cvt_pk_bf16(float lo, float hi) { const f32x2_t v = {lo, hi}; const bf16x2_t b = __builtin_convertvector(v, bf16x2_t); return __builtin_bit_cast(unsigned, b); }
__device__ __forceinline__ float silu_e(float x) { return x * __builtin_amdgcn_rcpf(1.0f + __expf(-x)); }
__device__ __forceinline__ float sigm_e(float x) { return __builtin_amdgcn_rcpf(1.0f + __expf(-x)); }
__device__ __forceinline__ u32x4 pack8(const f32x4 a, const f32x4 b) { u32x4 w; w.x = cvt_pk_bf16(a[0], a[1]); w.y = cvt_pk_bf16(a[2], a[3]); w.z = cvt_pk_bf16(b[0], b[1]); w.w = cvt_pk_bf16(b[2], b[3]); return w; }

struct EpiSwiGLU {
    static constexpr bool PERM = true, AFTER_DRAIN = false, HAS_MID = false;
    bf16_t* T; int ldt;
    __device__ __forceinline__ void operator()(const f32x4 (&acc)[2][2][4][2], const Unit& u, int wr, int wc, int fr, int fq) const {
        const int row0 = u.pm * BM + wr * 64 + fr, col0 = u.pn * HALF + wc * 32 + 8 * fq;
#pragma unroll
        for (int ai = 0; ai < 2; ++ai)
#pragma unroll
            for (int m = 0; m < 4; ++m) {
                f32x4 o0, o1;
#pragma unroll
                for (int i = 0; i < 4; ++i) { o0[i] = silu_e(acc[ai][0][m][0][i]) * acc[ai][1][m][0][i]; o1[i] = silu_e(acc[ai][0][m][1][i]) * acc[ai][1][m][1][i]; }
                *(u32x4*)(T + (size_t)(row0 + ai * HALF + m * 16) * ldt + col0) = pack8(o0, o1);
            }
    }
};
struct EpiResid {
    static constexpr bool PERM = false, AFTER_DRAIN = false, HAS_MID = false;
    float* X; const float* mod; int moff; float sc; const float* xin;
    __device__ __forceinline__ void operator()(const f32x4 (&acc)[2][2][4][2], const Unit& u, int wr, int wc, int fr, int fq) const {
        const int row0 = u.pm * BM + wr * 64 + fr, col0 = (u.pn & 0xff) * BM + wc * 32 + 4 * fq; const int nkt = un_nkt(u); float* part = (float*)((char*)X + (OFF_PART - OFF_X)) + (size_t)un_slice(u) * MS * DM;
#pragma unroll
        for (int ai = 0; ai < 2; ++ai)
#pragma unroll
            for (int m = 0; m < 4; ++m) { const int row = row0 + ai * HALF + m * 16; const int sq = seq_of_row(row);
                const float* mp = mod + (size_t)sq * MODLD + moff + col0; float* xp = X + (size_t)row * DM + col0;
#pragma unroll
                for (int bj = 0; bj < 2; ++bj)
#pragma unroll
                    for (int n = 0; n < 2; ++n) { const int off = bj * HALF + n * 16; const f32x4 mv = *(const f32x4*)(mp + off);
                        if (nkt == 0) { f32x4 xv = *(const f32x4*)(xin + (size_t)row * DM + col0 + off); xv = xv + (mv * sc) * acc[ai][bj][m][n]; *(f32x4*)(xp + off) = xv; }
                        else { const f32x4 dv = (mv * sc) * acc[ai][bj][m][n];
                            if (sc != 0.f) *(f32x4*)(part + (size_t)(row - MP) * DM + col0 + off) = dv; }     } }
    }
};
struct EpiInProj {
    static constexpr bool PERM = true, AFTER_DRAIN = false, HAS_MID = false;
    float* PA; bf16_t* PB; bf16_t* G;
    __device__ __forceinline__ void operator()(const f32x4 (&acc)[2][2][4][2], const Unit& u, int wr, int wc, int fr, int fq) const {
        const int row0 = u.pm * BM + wr * 64 + fr, cl = wc * 32 + 8 * fq;
        if (u.pn < 14) {
#pragma unroll
            for (int ai = 0; ai < 2; ++ai)
#pragma unroll
                for (int m = 0; m < 4; ++m) { float* p = PA + (size_t)(row0 + ai * HALF + m * 16) * APAD + u.pn * BM + cl;
#pragma unroll
                    for (int bj = 0; bj < 2; ++bj) { *(f32x4*)(p + bj * HALF) = acc[ai][bj][m][0]; *(f32x4*)(p + bj * HALF + 4) = acc[ai][bj][m][1]; } }
        } else if (u.pn < 20) {
#pragma unroll
            for (int ai = 0; ai < 2; ++ai)
#pragma unroll
                for (int m = 0; m < 4; ++m) { bf16_t* p = PB + (size_t)(row0 + ai * HALF + m * 16) * BPROJ + (u.pn - 14) * BM + cl;
#pragma unroll
                    for (int bj = 0; bj < 2; ++bj) *(u32x4*)(p + bj * HALF) = pack8(acc[ai][bj][m][0], acc[ai][bj][m][1]); }
        } else {
#pragma unroll
            for (int ai = 0; ai < 2; ++ai)
#pragma unroll
                for (int m = 0; m < 4; ++m) { bf16_t* p = G + (size_t)(row0 + ai * HALF + m * 16) * (2 * DM) + (u.pn - 20) * BM + cl;
#pragma unroll
                    for (int bj = 0; bj < 2; ++bj) { f32x4 a = acc[ai][bj][m][0], b = acc[ai][bj][m][1];
#pragma unroll
                        for (int i = 0; i < 4; ++i) { a[i] = sigm_e(a[i]); b[i] = sigm_e(b[i]); }
                        *(u32x4*)(p + bj * HALF) = pack8(a, b); } }
        }
    }
};
struct EpiF32 {
    static constexpr bool PERM = false, AFTER_DRAIN = false, HAS_MID = false;
    float* C; int ldc; const float* bias;
    __device__ __forceinline__ void operator()(const f32x4 (&acc)[2][2][4][2], const Unit& u, int wr, int wc, int fr, int fq) const {
        const int row0 = u.pm * BM + wr * 64 + fr, col0 = u.pn * BM + wc * 32 + 4 * fq;
        f32x4 bv[2][2];
#pragma unroll
        for (int bj = 0; bj < 2; ++bj)
#pragma unroll
            for (int n = 0; n < 2; ++n) bv[bj][n] = bias ? *(const f32x4*)(bias + col0 + bj * HALF + n * 16) : (f32x4){0.f, 0.f, 0.f, 0.f};
#pragma unroll
        for (int ai = 0; ai < 2; ++ai)
#pragma unroll
            for (int m = 0; m < 4; ++m) { float* rowp = C + (size_t)(row0 + ai * HALF + m * 16) * ldc + col0;
#pragma unroll
                for (int bj = 0; bj < 2; ++bj)
#pragma unroll
                    for (int n = 0; n < 2; ++n) *(f32x4*)(rowp + bj * HALF + n * 16) = acc[ai][bj][m][n] + bv[bj][n]; }
    }
};
struct EpiBranch {
    static constexpr bool PERM = true, AFTER_DRAIN = false, HAS_MID = true;
    const bf16_t* G; bf16_t* MRG;
    __device__ __forceinline__ void mid(f32x4 (&acc)[2][2][4][2], const Unit& u, int wr, int wc, int fr, int fq) const {
        const int row0 = (u.pm & 0xff) * BM + wr * 64 + fr, col0 = (u.pn & 0xff) * BM + wc * 32 + 8 * fq;
#pragma unroll
        for (int ai = 0; ai < 2; ++ai)
#pragma unroll
            for (int m = 0; m < 4; ++m) { const int row = row0 + ai * HALF + m * 16;
#pragma unroll
                for (int bj = 0; bj < 2; ++bj) { const bf16_t* gp = G + (size_t)row * (2 * DM) + col0 + bj * HALF; const u32x4 ga = *(const u32x4*)gp, gb = *(const u32x4*)(gp + DM);
                    const unsigned gaw[4] = {ga.x, ga.y, ga.z, ga.w}, gbw[4] = {gb.x, gb.y, gb.z, gb.w};
#pragma unroll
                    for (int w = 0; w < 4; ++w) { const float a0 = __uint_as_float(gaw[w] << 16), a1 = __uint_as_float(gaw[w] & 0xffff0000u), b0 = fmaxf(__uint_as_float(gbw[w] << 16), 1e-30f), b1 = fmaxf(__uint_as_float(gbw[w] & 0xffff0000u), 1e-30f);
                        acc[ai][bj][m][w >> 1][2 * (w & 1)] *= a0 * __builtin_amdgcn_rcpf(b0); acc[ai][bj][m][w >> 1][2 * (w & 1) + 1] *= a1 * __builtin_amdgcn_rcpf(b1); } } }
    }
    __device__ __forceinline__ void operator()(const f32x4 (&acc)[2][2][4][2], const Unit& u, int wr, int wc, int fr, int fq) const {
        const int row0 = (u.pm & 0xff) * BM + wr * 64 + fr, col0 = (u.pn & 0xff) * BM + wc * 32 + 8 * fq;
#pragma unroll
        for (int ai = 0; ai < 2; ++ai)
#pragma unroll
            for (int m = 0; m < 4; ++m) { const int row = row0 + ai * HALF + m * 16;
#pragma unroll
                for (int bj = 0; bj < 2; ++bj) { const u32x4 g = *(const u32x4*)(G + (size_t)row * (2 * DM) + DM + col0 + bj * HALF);
                    f32x4 a = acc[ai][bj][m][0], b = acc[ai][bj][m][1];
                    a[0] *= fmaxf(__uint_as_float(g.x << 16), 1e-30f); a[1] *= fmaxf(__uint_as_float(g.x & 0xffff0000u), 1e-30f); a[2] *= fmaxf(__uint_as_float(g.y << 16), 1e-30f); a[3] *= fmaxf(__uint_as_float(g.y & 0xffff0000u), 1e-30f);
                    b[0] *= fmaxf(__uint_as_float(g.z << 16), 1e-30f); b[1] *= fmaxf(__uint_as_float(g.z & 0xffff0000u), 1e-30f); b[2] *= fmaxf(__uint_as_float(g.w << 16), 1e-30f); b[3] *= fmaxf(__uint_as_float(g.w & 0xffff0000u), 1e-30f);
                    *(u32x4*)(MRG + (size_t)row * DM + col0 + bj * HALF) = pack8(a, b); } }
    }
};
template <class Epi, class Sched, bool ALIGN_EPI = false, bool SP2 = false>
__device__ __forceinline__ void gemm_phase(PG8_LAS unsigned char* lds, const Gemm g, const Sched& S, const Epi& E, const int tid) {
    const int wid = __builtin_amdgcn_readfirstlane(tid >> 6), lane = tid & 63, wr = wid >> 2, wc = wid & 3, fr = lane & 15, fq = lane >> 4;
    const int K = g.K, nt_all = K / BK;
    unsigned voffA[2], voffB[2];
#pragma unroll
    for (int i = 0; i < 2; ++i) { int R, C; stage_rc(tid * 16 + i * 8192, R, C); const int Rb = Epi::PERM ? ((R & ~31) + perm32(R & 31)) : R;
        voffA[i] = (unsigned)(R * K + C) * 2u; voffB[i] = (unsigned)(Rb * K + C) * 2u; }
    const size_t kstep = (size_t)(BK * 2);
    const size_t hstep = (size_t)HALF * K * 2;
    const size_t tstep = 2 * hstep;
    const unsigned ldsw = (unsigned)wid * 1024u;
    const int aoff = lds_byte(wr * 64 + fr, fq * 8), boff = lds_byte(wc * 32 + fr, fq * 8);
#define PG8_SA(b, h) (((b) * 2 + (h)) * HTB)
#define PG8_SB(b, h) ((4 + (b) * 2 + (h)) * HTB)
#define PG8_STAGE(bufoff, gbase, voff) do { _Pragma("unroll") for (int _i = 0; _i < 2; ++_i) \
        __builtin_amdgcn_global_load_lds((const unsigned*)((const char*)(gbase) + (voff)[_i]), (PG8_LAS unsigned*)(lds + (bufoff) + ldsw + _i * 8192), 16, 0, 0); } while (0)
#define PG8_LDA(dst, b, h) do { _Pragma("unroll") for (int m = 0; m < 4; ++m) _Pragma("unroll") for (int k = 0; k < 2; ++k) dst[m][k] = *(const PG8_LAS bf16x8*)(lds + PG8_SA(b, h) + aoff + m * 2048 + k * 1024); } while (0)
#define PG8_LDB(dst, b, h) do { _Pragma("unroll") for (int n = 0; n < 2; ++n) _Pragma("unroll") for (int k = 0; k < 2; ++k) dst[n][k] = *(const PG8_LAS bf16x8*)(lds + PG8_SB(b, h) + boff + n * 2048 + k * 1024); } while (0)
#define PG8_MMA(ai, bj, At, Bt) do { __builtin_amdgcn_s_setprio(1); _Pragma("unroll") for (int m = 0; m < 4; ++m) _Pragma("unroll") for (int n = 0; n < 2; ++n) _Pragma("unroll") for (int k = 0; k < 2; ++k) \
        acc[ai][bj][m][n] = __builtin_amdgcn_mfma_f32_16x16x32_bf16(Bt[n][k], At[m][k], acc[ai][bj][m][n], 0, 0, 0); __builtin_amdgcn_s_setprio(0); } while (0)
#define PG8_WAIT_V(n) asm volatile("s_waitcnt vmcnt(" #n ")" ::: "memory")
#define PG8_WAIT_L(n) asm volatile("s_waitcnt lgkmcnt(" #n ")" ::: "memory")
#define PG8_BAR __builtin_amdgcn_s_barrier()
#define PG8_SCHED __builtin_amdgcn_sched_barrier(0)
    Unit cur, nxt; int ui = 0;
    if (!S.next(0, cur)) return;
    f32x4 acc[2][2][4][2];
#pragma unroll
    for (int a = 0; a < 2; ++a)
#pragma unroll
        for (int b = 0; b < 2; ++b)
#pragma unroll
            for (int m = 0; m < 4; ++m)
#pragma unroll
                for (int n = 0; n < 2; ++n) acc[a][b][m][n] = (f32x4){0.f, 0.f, 0.f, 0.f};
    bf16x8 At[4][2], B0[2][2], B1[2][2];
    const char* cA = (const char*)((cur.pm >> 8) ? g.A2 : g.A) + (size_t)(cur.pm & 0xff) * tstep + (size_t)un_kt0(cur) * (BK * 2); const char* cB = (const char*)((cur.pm >> 8) ? g.Bt2 : g.Bt) + (size_t)(cur.pn & 0xff) * tstep + (size_t)un_kt0(cur) * (BK * 2);
    S.a_ready(cur);
    if constexpr (SP2) {
        PG8_STAGE(PG8_SB(0, 0), cB, voffB); PG8_STAGE(PG8_SB(0, 1), cB + hstep, voffB); PG8_STAGE(PG8_SA(0, 0), cA, voffA); PG8_STAGE(PG8_SA(0, 1), cA + hstep, voffA);
        if (wr == 1) PG8_BAR;
        PG8_WAIT_V(2); PG8_BAR;
        PG8_STAGE(PG8_SB(1, 0), cB + kstep, voffB); PG8_STAGE(PG8_SA(1, 0), cA + kstep, voffA); PG8_STAGE(PG8_SB(1, 1), cB + hstep + kstep, voffB);
        PG8_WAIT_V(6); PG8_BAR;
    } else {
        PG8_STAGE(PG8_SB(0, 0), cB, voffB); PG8_STAGE(PG8_SA(0, 0), cA, voffA); PG8_STAGE(PG8_SB(0, 1), cB + hstep, voffB); PG8_STAGE(PG8_SA(0, 1), cA + hstep, voffA);
        if (wr == 1) PG8_BAR;
        PG8_WAIT_V(4); PG8_BAR;
        PG8_STAGE(PG8_SB(1, 0), cB + kstep, voffB); PG8_STAGE(PG8_SA(1, 0), cA + kstep, voffA); PG8_STAGE(PG8_SB(1, 1), cB + hstep + kstep, voffB);
        PG8_WAIT_V(6); PG8_BAR;
    }
    for (;;) {
        const bool has_next = S.next(ui + 1, nxt);
        const char* nA = has_next ? (const char*)((nxt.pm >> 8) ? g.A2 : g.A) + (size_t)(nxt.pm & 0xff) * tstep + (size_t)un_kt0(nxt) * (BK * 2) : cA; const char* nB = has_next ? (const char*)((nxt.pm >> 8) ? g.Bt2 : g.Bt) + (size_t)(nxt.pn & 0xff) * tstep + (size_t)un_kt0(nxt) * (BK * 2) : cB;
        const int nt = un_nkt(cur) ? un_nkt(cur) : nt_all;
        for (int t = 0; t < nt; t += 2) {
            const bool last = (t == nt - 2);
            const char* a1 = cA + (size_t)(t + 1) * kstep;
            const char* a2 = last ? nA : cA + (size_t)(t + 2) * kstep; const char* b2 = last ? nB : cB + (size_t)(t + 2) * kstep;
            const char* a3 = a2 + kstep; const char* b3 = b2 + kstep;
            if (last && has_next) S.a_ready(nxt);
            if constexpr (SP2) {
            PG8_LDB(B0, 0, 0); PG8_LDB(B1, 0, 1); PG8_SCHED; PG8_LDA(At, 0, 0); PG8_STAGE(PG8_SA(1, 1), a1 + hstep, voffA);
            PG8_WAIT_V(8); PG8_WAIT_L(0); PG8_BAR; PG8_MMA(0, 0, At, B0); PG8_MMA(0, 1, At, B1); PG8_BAR; PG8_SCHED;
            PG8_LDA(At, 0, 1); PG8_STAGE(PG8_SB(0, 0), b2, voffB); PG8_STAGE(PG8_SB(0, 1), b2 + hstep, voffB); PG8_STAGE(PG8_SA(0, 0), a2, voffA);
            PG8_WAIT_V(8); PG8_WAIT_L(0); PG8_BAR; PG8_MMA(1, 0, At, B0); PG8_MMA(1, 1, At, B1); PG8_BAR; PG8_SCHED;
            PG8_LDB(B0, 1, 0); PG8_LDB(B1, 1, 1); PG8_SCHED; PG8_LDA(At, 1, 0); PG8_STAGE(PG8_SA(0, 1), a2 + hstep, voffA);
            PG8_WAIT_V(8); PG8_WAIT_L(0); PG8_BAR; PG8_MMA(0, 0, At, B0); PG8_MMA(0, 1, At, B1); PG8_BAR; PG8_SCHED;
            PG8_LDA(At, 1, 1); PG8_STAGE(PG8_SB(1, 0), b3, voffB); PG8_STAGE(PG8_SB(1, 1), b3 + hstep, voffB); PG8_STAGE(PG8_SA(1, 0), a3, voffA);
            PG8_WAIT_V(8); PG8_WAIT_L(0); PG8_BAR; PG8_MMA(1, 0, At, B0); PG8_MMA(1, 1, At, B1); PG8_BAR; PG8_SCHED;
            } else {
            PG8_LDB(B0, 0, 0); PG8_SCHED; PG8_LDA(At, 0, 0); PG8_STAGE(PG8_SA(1, 1), a1 + hstep, voffA);
            PG8_WAIT_L(8); PG8_BAR; PG8_WAIT_L(0); PG8_MMA(0, 0, At, B0); PG8_BAR; PG8_SCHED;
            PG8_LDB(B1, 0, 1); PG8_STAGE(PG8_SB(0, 0), b2, voffB);
            PG8_BAR; PG8_WAIT_L(0); PG8_MMA(0, 1, At, B1); PG8_BAR;
            PG8_LDA(At, 0, 1); PG8_STAGE(PG8_SA(0, 0), a2, voffA);
            PG8_BAR; PG8_WAIT_L(0); PG8_MMA(1, 0, At, B0); PG8_BAR; PG8_SCHED;
            PG8_STAGE(PG8_SB(0, 1), b2 + hstep, voffB);
            PG8_WAIT_V(6); PG8_BAR; PG8_MMA(1, 1, At, B1); PG8_BAR;
            PG8_LDB(B0, 1, 0); PG8_SCHED; PG8_LDA(At, 1, 0); PG8_STAGE(PG8_SA(0, 1), a2 + hstep, voffA);
            PG8_WAIT_L(8); PG8_BAR; PG8_WAIT_L(0); PG8_MMA(0, 0, At, B0); PG8_BAR; PG8_SCHED;
            PG8_LDB(B1, 1, 1); PG8_STAGE(PG8_SB(1, 0), b3, voffB);
            PG8_BAR; PG8_WAIT_L(0); PG8_MMA(0, 1, At, B1); PG8_BAR;
            PG8_LDA(At, 1, 1); PG8_STAGE(PG8_SA(1, 0), a3, voffA);
            PG8_BAR; PG8_WAIT_L(0); PG8_MMA(1, 0, At, B0); PG8_BAR; PG8_SCHED;
            PG8_STAGE(PG8_SB(1, 1), b3 + hstep, voffB);
            PG8_WAIT_V(6); PG8_BAR; PG8_MMA(1, 1, At, B1); PG8_BAR;
            }
        }
        if constexpr (ALIGN_EPI) { if (wr == 0) PG8_BAR; }
        bool keep_acc = false;
        if constexpr (Epi::HAS_MID) { if ((cur.pm >> 8) == 0) { E.mid(acc, cur, wr, wc, fr, fq); keep_acc = true; } }
        if constexpr (!Epi::AFTER_DRAIN) { if (!keep_acc) { E(acc, cur, wr, wc, fr, fq); S.done(cur); } }
        if (!has_next) break;
        if (!keep_acc) {
#pragma unroll
        for (int a = 0; a < 2; ++a)
#pragma unroll
            for (int b = 0; b < 2; ++b)
#pragma unroll
                for (int m = 0; m < 4; ++m)
#pragma unroll
                    for (int n = 0; n < 2; ++n) acc[a][b][m][n] = (f32x4){0.f, 0.f, 0.f, 0.f};
        }
        cur = nxt; cA = nA; cB = nB; ++ui;
        if constexpr (ALIGN_EPI) { if (wr == 1) PG8_BAR; }
    }
    PG8_WAIT_V(0);
    if constexpr (!ALIGN_EPI) { if (wr == 0) PG8_BAR; }
    PG8_BAR;
    if constexpr (Epi::AFTER_DRAIN) { E.fused(acc, cur, wr, wc, fr, fq, lds, wid, lane); S.done(cur); }
#undef PG8_SA
#undef PG8_SB
#undef PG8_STAGE
#undef PG8_LDA
#undef PG8_LDB
#undef PG8_MMA
#undef PG8_WAIT_V
#undef PG8_WAIT_L
#undef PG8_BAR
#undef PG8_SCHED
}
}
#define XB_TMO      128
#define XB_XCNT(j)  (256  + 64 * (j))
#define XB_XSUB(j)  (1280 + 64 * (j))
#define XB_XGEN(j)  (2304 + 64 * (j))
#define XB_TOP      3328
#define XB_TOPGEN   3392
#define XCD_BAR_WORDS 3456
#define XB_SPIN_CAP (1u << 18)

__device__ __forceinline__ unsigned xb_ld(unsigned* p)              { return __hip_atomic_load(p, __ATOMIC_RELAXED, __HIP_MEMORY_SCOPE_AGENT); }
__device__ __forceinline__ unsigned xb_add(unsigned* p, unsigned v) { return __hip_atomic_fetch_add(p, v, __ATOMIC_RELAXED, __HIP_MEMORY_SCOPE_AGENT); }
__device__ __forceinline__ unsigned xb_xcc_id() { return (unsigned)__builtin_amdgcn_s_getreg((3 << 11) | 20) & 0xFu; }
#define XB_SPIN(cond, bar) do { unsigned _sp = 0; while (cond) { __builtin_amdgcn_s_sleep(1); \
    if ((++_sp & 255u) == 0u) { if (xb_ld(&(bar)[XB_TMO])) break; if (_sp > XB_SPIN_CAP) { atomicAdd(&(bar)[XB_TMO], 1u); break; } } } } while (0)

struct XcdBarrier {
    unsigned* bar; unsigned x;
    volatile LAS unsigned* st;
};

__device__ __forceinline__ XcdBarrier xcd_barrier_post(unsigned* bar, volatile LAS unsigned* st) {
    XcdBarrier b; b.bar = bar; b.x = xb_xcc_id(); b.st = st;
    if (threadIdx.x == 0) (void)xb_add(&bar[XB_XCNT(b.x)], 1u);
    return b;
}
__device__ __forceinline__ void xcd_barrier_complete(unsigned* bar, unsigned x, unsigned& nloc, unsigned& nx) {
    const unsigned G = gridDim.x * gridDim.y * gridDim.z;
    unsigned sum, cnt, mine, sp = 0u;
    for (;;) {
        sum = 0u; cnt = 0u; mine = 0u;
#pragma unroll
        for (unsigned j = 0; j < 16; ++j) { const unsigned c = xb_ld(&bar[XB_XCNT(j)]); sum += c; cnt += (c > 0u) ? 1u : 0u; mine = (j == x) ? c : mine; }
        if (sum == G) break;
        __builtin_amdgcn_s_sleep(1);
        if ((++sp & 255u) == 0u) { if (xb_ld(&bar[XB_TMO])) break; if (sp > XB_SPIN_CAP) { atomicAdd(&bar[XB_TMO], 1u); break; } }
    }
    nloc = mine > 0u ? mine : 1u; nx = cnt > 0u ? cnt : 1u;
}

__device__ __forceinline__ void xcd_barrier_census(const XcdBarrier& b) {
    if (threadIdx.x == 0) { unsigned nloc, nx; xcd_barrier_complete(b.bar, b.x, nloc, nx); b.st[0] = nloc; b.st[1] = nx; }
    __syncthreads();
}
__device__ __forceinline__ void xcd_barrier(const XcdBarrier& b) {
    asm volatile("s_waitcnt vmcnt(0)" ::: "memory");
    __syncthreads();
    if (threadIdx.x == 0) {
        unsigned* bar = b.bar;
        __builtin_amdgcn_s_waitcnt(0);
        unsigned nloc = b.st[0], nx = b.st[1];
        const unsigned old = xb_add(&bar[XB_XSUB(b.x)], 1u);
        const unsigned gen = old / nloc;
        if (old + 1u == (gen + 1u) * nloc) {
            __builtin_amdgcn_fence(__ATOMIC_RELEASE, "agent");
            asm volatile("s_waitcnt vmcnt(0)" ::: "memory");
            const unsigned og = xb_add(&bar[XB_TOP], 1u);
            const unsigned tg = og / nx;
            if (og + 1u == (tg + 1u) * nx) xb_add(&bar[XB_TOPGEN], 1u);
            else XB_SPIN(xb_ld(&bar[XB_TOPGEN]) == tg, bar);
            __builtin_amdgcn_fence(__ATOMIC_ACQUIRE, "agent");
            xb_add(&bar[XB_XGEN(b.x)], 1u);
            asm volatile("s_waitcnt vmcnt(0)" ::: "memory");
        } else {
            XB_SPIN(xb_ld(&bar[XB_XGEN(b.x)]) == gen, bar);
            __builtin_amdgcn_fence(__ATOMIC_ACQUIRE, "agent");
            asm volatile("s_waitcnt vmcnt(0)" ::: "memory");
        }
    }
    __syncthreads();
}

constexpr int RING_OFF = 0, RING_BYTES = 131072;
constexpr int LDSCTL_OFF = 159744, MISC_OFF = LDSCTL_OFF + 320;
constexpr int LDS_BYTES = 163840;
constexpr int NWAVES = 8;

#define RLX_AGENT __ATOMIC_RELAXED, __HIP_MEMORY_SCOPE_AGENT
#define WS_DPP(v, ctrl) __int_as_float(__builtin_amdgcn_update_dpp(0, __float_as_int(v), (ctrl), 0xF, 0xF, true))
__device__ __forceinline__ float wave_sum(float v) {
    v += WS_DPP(v, 0xB1); v += WS_DPP(v, 0x4E); v += WS_DPP(v, 0x141); v += WS_DPP(v, 0x140);
    return (__int_as_float(__builtin_amdgcn_readlane(__float_as_int(v), 0)) + __int_as_float(__builtin_amdgcn_readlane(__float_as_int(v), 16))) + (__int_as_float(__builtin_amdgcn_readlane(__float_as_int(v), 32)) + __int_as_float(__builtin_amdgcn_readlane(__float_as_int(v), 48)));
}
__device__ __forceinline__ float wave_max(float v) {
#pragma unroll
    for (int o = 1; o < 64; o <<= 1) v = fmaxf(v, __shfl_xor(v, o));
    return v;
}
__device__ __forceinline__ float ld_agent(const float* p) { return __uint_as_float(__hip_atomic_load((const unsigned*)p, RLX_AGENT)); }

struct Args { const float* in[N_IN]; float* out; unsigned char* ws; int ph_lo, ph_hi, use_bar, pad; };
constexpr int PTAB_OFF = LDSCTL_OFF + 1024;
__device__ __forceinline__ const float* inp_ptr(int i) { extern __shared__ __attribute__((aligned(16))) unsigned char lds_raw_[]; const LAS unsigned* t = (const LAS unsigned*)((LAS unsigned char*)lds_raw_ + PTAB_OFF) + 2 * i;
    const unsigned lo = __builtin_amdgcn_readfirstlane(t[0]), hi = __builtin_amdgcn_readfirstlane(t[1]); return (const float*)(const GAS float*)(((unsigned long long)hi << 32) | lo); }
#define INP(i) inp_ptr(i)


__device__ __forceinline__ void cvt_item(const float* __restrict__ W, int N, bf16* WT, int ldk, int k0, int n0, int drow0, LAS float* scr, int lane) {
    const int rr = lane >> 3, c4 = (lane & 7) * 4;
#pragma unroll
    for (int i = 0; i < 8; ++i) { const int kk = 8 * i + rr; const v4f v = *(const v4f*)(W + (size_t)(k0 + kk) * N + n0 + c4); LAS float* d = scr + kk * 33 + c4; d[0] = v.x; d[1] = v.y; d[2] = v.z; d[3] = v.w; }
    asm volatile("s_waitcnt lgkmcnt(0)" ::: "memory");
    const int c = lane & 7;
#pragma unroll
    for (int j = 0; j < 4; ++j) { const int n = (lane >> 3) + 8 * j; const LAS float* s = scr + (8 * c) * 33 + n;
        v4u o; o.x = pk2(s[0 * 33], s[1 * 33]); o.y = pk2(s[2 * 33], s[3 * 33]); o.z = pk2(s[4 * 33], s[5 * 33]); o.w = pk2(s[6 * 33], s[7 * 33]);
        *(v4u*)(WT + (size_t)(drow0 + n) * ldk + k0 + 8 * c) = o; }
    asm volatile("s_waitcnt lgkmcnt(0)" ::: "memory");
}
__device__ __forceinline__ void p0_phase(const Args& a, LAS unsigned char* lds, int vcu, int G, int wave, int lane) {
    LAS float* scr = (LAS float*)(lds + wave * 16384);
    const int gw = vcu * NWAVES + wave, NGW = G * NWAVES;
    unsigned char* ws = a.ws;
    constexpr int I_GU = (DM / 64) * (DFF / 32), I_D = (DFF / 64) * (DM / 32), I_IN = (DM / 64) * (4896 / 32), I_MG = (DM / 64) * (2 * DM / 32), I_AB = (AW / 64) * (DM / 32), I_OUT = (DM / 64) * (DM / 32), I_MOD = (DM / 64) * (NMODC / 32);
    constexpr int I_LAYER = 4 * I_GU + 2 * I_D + I_IN + I_MG + 2 * I_AB + I_OUT;
    for (int it = gw; it < DEPTH * I_LAYER; it += NGW) {
        const int l = it / I_LAYER; int r = it - l * I_LAYER;
        if (r < 4 * I_GU) { const int which = r / I_GU, f = which & 1, up = which >> 1; r -= which * I_GU; const int nb = DFF / 32, kb = r / nb, n0 = 32 * (r % nb);
            cvt_item(INP(up ? I_FU : I_FG) + (size_t)(l * 2 + f) * DM * DFF, DFF, (bf16*)(ws + OFF_WGU + (size_t)(l * 2 + f) * SZ_WGU), DM, 64 * kb, n0, 256 * (n0 >> 7) + (n0 & 127) + 128 * up, scr, lane); continue; } r -= 4 * I_GU;
        if (r < 2 * I_D) { const int f = r / I_D; r -= f * I_D; const int nb = DM / 32, kb = r / nb, n0 = 32 * (r % nb);
            cvt_item(INP(I_FD) + (size_t)(l * 2 + f) * DFF * DM, DM, (bf16*)(ws + OFF_WD + (size_t)(l * 2 + f) * SZ_WD), DFF, 64 * kb, n0, n0, scr, lane); continue; } r -= 2 * I_D;
        if (r < I_IN) { const int nb = 4896 / 32, kb = r / nb, n0 = 32 * (r % nb);
            cvt_item(INP(I_WIN) + (size_t)l * DM * 4896, 4896, (bf16*)(ws + OFF_WIN + (size_t)l * SZ_WIN), DM, 64 * kb, n0, n0 < APROJ ? n0 : n0 + (APAD - APROJ), scr, lane); continue; } r -= I_IN;
        if (r < I_MG) { const int nb = 2 * DM / 32, kb = r / nb, n0 = 32 * (r % nb);
            cvt_item(INP(I_WMG) + (size_t)l * DM * 2 * DM, 2 * DM, (bf16*)(ws + OFF_WIN + (size_t)l * SZ_WIN), DM, 64 * kb, n0, APAD + BPROJ + n0, scr, lane); continue; } r -= I_MG;
        if (r < 2 * I_AB) { const int wb = r / I_AB; r -= wb * I_AB; const int nb = DM / 32, kb = r / nb, n0 = 32 * (r % nb);
            cvt_item(INP(wb ? I_WB : I_WA) + (size_t)l * AW * DM, DM, (bf16*)(ws + (wb ? OFF_WB : OFF_WA) + (size_t)l * SZ_WAB), AW, 64 * kb, n0, n0, scr, lane); continue; } r -= 2 * I_AB;
        { const int nb = DM / 32, kb = r / nb, n0 = 32 * (r % nb);
            cvt_item(INP(I_WOUT) + (size_t)l * DM * DM, DM, (bf16*)(ws + OFF_WOUT + (size_t)l * SZ_WOUT), DM, 64 * kb, n0, n0, scr, lane); }
    }
    const int gt = gw * 64 + lane, NGT = NGW * 64;
    { bf16* A = (bf16*)(ws + OFF_AMOD);
      for (int i = gt; i < 256 * DM; i += NGT) { const int row = i >> 11, c = i & (DM - 1); float v = 0.f;
          if (row < NBATCH) v = siluf_(INP(I_CP)[row * DM + c]); else if (row < NSEQ) v = siluf_(INP(I_CS)[(row - NBATCH) * DM + c]);
          A[i] = (bf16)f2bf(v); } }
    for (int i = gt; i < DEPTH * LN3 * LK; i += NGT) { const int l = i / (LN3 * LK), rem = i - l * (LN3 * LK), row = rem / LK, k = rem - row * LK; float v = 0.f;
        if (row < 1024) { if (k < 64) v = INP(I_W2)[((size_t)l * 64 + k) * AW + row]; }
        else if (row < 2048) { if (k >= 64 && k < 128) v = INP(I_A2)[((size_t)l * 64 + (k - 64)) * AW + (row - 1024)]; }
        else { if (k >= 128 && k < 288) v = INP(I_G2)[((size_t)l * 160 + (k - 128)) * AW + (row - 2048)]; }
        ((bf16*)(ws + OFF_WL))[i] = (bf16)f2bf(v); }
    for (int i = gt; i < DEPTH * (APAD - APROJ) * DM / 8; i += NGT) { const int l = i / ((APAD - APROJ) * DM / 8), rem = i - l * ((APAD - APROJ) * DM / 8);
        *(v4u*)(ws + OFF_WIN + (size_t)l * SZ_WIN + (size_t)APROJ * DM * 2 + (size_t)rem * 16) = (v4u){0u, 0u, 0u, 0u}; }
}

__device__ __forceinline__ void norm_phase(float* X, const float* gain, const float* MOD, int moff_shift, int moff_scale, bf16* H, int gw, int NGW, int lane, const float* part, int nparts, const float* xp0, const float* xs0) {
    for (int row = gw; row < MT; row += NGW) {
        v4f* xr = (v4f*)(X + (size_t)row * DM) + lane; v4f v[8]; float ss = 0.f;
        const v4f* xsrc = row < MP ? (xp0 ? (const v4f*)(xp0 + (size_t)row * DM) + lane : xr) : (xs0 ? (const v4f*)(xs0 + (size_t)(row - MP) * DM) + lane : xr);
#pragma unroll
        for (int j = 0; j < 8; ++j) v[j] = xsrc[64 * j];
        if (row >= MP && nparts > 0) {
            for (int s = 0; s < nparts; ++s) { const v4f* pr = (const v4f*)(part + ((size_t)s * MS + (row - MP)) * DM) + lane;
#pragma unroll
                for (int j = 0; j < 8; ++j) v[j] = v[j] + pr[64 * j]; }
#pragma unroll
            for (int j = 0; j < 8; ++j) xr[64 * j] = v[j]; }
#pragma unroll
        for (int j = 0; j < 8; ++j) { ss += (v[j].x * v[j].x + v[j].y * v[j].y) + (v[j].z * v[j].z + v[j].w * v[j].w); }
        const float rstd = 1.0f / sqrtf(wave_sum(ss) * (1.0f / DM) + RMS_EPS);
        const int sq = seq_of_row(row);
        const v4f* sh = (const v4f*)(MOD + (size_t)sq * MODLD + moff_shift) + lane; const v4f* sc = (const v4f*)(MOD + (size_t)sq * MODLD + moff_scale) + lane; const v4f* gp = (const v4f*)gain + lane;
        v2u* o8 = (v2u*)(H + (size_t)row * DM) + lane;
#pragma unroll
        for (int j = 0; j < 8; ++j) { const v4f g = gp[64 * j], s = sc[64 * j], h = sh[64 * j]; const v4f y = v[j] * rstd * g * (s + 1.0f) + h;
            v2u w; w.x = pk2(y.x, y.y); w.y = pk2(y.z, y.w); o8[64 * j] = w; }
    }
}
__device__ __forceinline__ void final_norm_phase(const float* X, const float* gain, float* out, int gw, int NGW, int lane, const float* part, int nparts) {
    for (int row = gw; row < MT; row += NGW) {
        const v4f* xr = (const v4f*)(X + (size_t)row * DM) + lane; v4f v[8]; float ss = 0.f;
#pragma unroll
        for (int j = 0; j < 8; ++j) v[j] = xr[64 * j];
        if (row >= MP) { for (int s = 0; s < nparts; ++s) { const v4f* pr = (const v4f*)(part + ((size_t)s * MS + (row - MP)) * DM) + lane;
#pragma unroll
                for (int j = 0; j < 8; ++j) v[j] = v[j] + pr[64 * j]; } }
#pragma unroll
        for (int j = 0; j < 8; ++j) { ss += (v[j].x * v[j].x + v[j].y * v[j].y) + (v[j].z * v[j].z + v[j].w * v[j].w); }
        const float rstd = 1.0f / sqrtf(wave_sum(ss) * (1.0f / DM) + RMS_EPS);
        const v4f* gp = (const v4f*)gain + lane; v4f* o = (v4f*)(out + (size_t)row * DM) + lane;
#pragma unroll
        for (int j = 0; j < 8; ++j) o[64 * j] = v[j] * rstd * gp[64 * j];
    }
}

struct Tok { int prompt, b, t, first, last, pos; };
__device__ __forceinline__ Tok tok_of(int row) { Tok k; if (row < MP) { k.prompt = 1; k.b = row >> 11; k.t = row & (SEQ - 1); k.first = k.t == 0; k.last = k.t == SEQ - 1; k.pos = k.t; }
    else { const int r = row - MP; k.prompt = 0; k.b = r >> 2; k.t = r & 3; k.first = k.t == 0; k.last = k.t == DSEQ - 1; k.pos = PAST + k.t; } return k; }
__device__ __forceinline__ size_t sc_record(const Tok& k, int h) { return k.prompt ? ((size_t)(k.b * AH + h) * SEQ + k.t) : ((size_t)NBATCH * AH * SEQ + (size_t)(k.b * AH + h) * DSEQ + k.t); }

__device__ __forceinline__ void e1_phase(const Args& a, int l, int gw, int NGW, int lane, int rope_sign) {
    unsigned char* ws = a.ws; const float* PA = (const float*)(ws + OFF_PA); bf16* PB = (bf16*)(ws + OFF_PB); bf16* LIN = (bf16*)(ws + OFF_LIN);
    const float* mu = INP(I_MU) + (size_t)l * APROJ;
    for (int row = gw; row < MT; row += NGW) {
        const Tok k = tok_of(row);
        const float* pa = PA + (size_t)row * APAD;
        const float* pv = k.first ? (k.prompt ? nullptr : INP(I_SSH) + ((size_t)l * DBATCH + k.b) * APROJ) : pa - APAD;
#pragma unroll
        for (int i = 0; i < 3; ++i) { const int p = lane + 64 * i;
            if (p < 160 && rope_sign != 0) { const int hd = p >> 3, i8 = p & 7; const int col = (hd < 16 ? hd * 64 : QW + (hd - 16) * 64) + i8;
                bf16* q = PB + (size_t)row * BPROJ + col; const float x1 = bf2f(q[0]), x2 = bf2f(q[8]);
                const float inv = exp2f(-(float)i8 * (18.931568569324174f / 8.0f)); const float ang = (float)k.pos * inv; float sn, cs; sincosf(ang, &sn, &cs); if (rope_sign < 0) sn = -sn;
                q[0] = (bf16)f2bf(x1 * cs - x2 * sn); q[8] = (bf16)f2bf(x2 * cs + x1 * sn); } }
        if (k.last) { float* o = a.out + (k.prompt ? OUT_SHP + ((size_t)l * NBATCH + k.b) * APROJ : OUT_SHS + ((size_t)l * DBATCH + k.b) * APROJ);
            for (int c = lane; c < APROJ; c += 64) o[c] = pa[c]; }
    }
}
__device__ __forceinline__ void e2_phase(const Args& a, int l, int gw, int NGW, int lane) {
    unsigned char* ws = a.ws; const float* PA = (const float*)(ws + OFF_PA); const float* LOUT = (const float*)(ws + OFF_LOUT); float* SC = (float*)(ws + OFF_R1); float* RK = (float*)(ws + OFF_RK);
    const float* mu = INP(I_MU) + (size_t)l * APROJ; const float* w0 = INP(I_W0) + l * AW; const float* a0 = INP(I_A0) + l * AW; const float* k_k = INP(I_KK) + l * AW; const float* k_a = INP(I_KA) + l * AW; const float* r_k = INP(I_RK) + l * AW;
    for (int row = gw; row < MT; row += NGW) {
        const Tok k = tok_of(row);
        const float* pa = PA + (size_t)row * APAD;
        const float* pv = k.first ? (k.prompt ? nullptr : INP(I_SSH) + ((size_t)l * DBATCH + k.b) * APROJ) : pa - APAD;
        const float* lo = LOUT + (size_t)row * LN3;
        for (int h = 0; h < AH; ++h) { const int col = h * 64 + lane;
            float xr = pa[col], xk = pa[AW + col], xv = pa[2 * AW + col];
            const float pr = pv ? pv[col] : 0.f, pk = pv ? pv[AW + col] : 0.f, pvv = pv ? pv[2 * AW + col] : 0.f;
            xr += (pr - xr) * mu[col]; xk += (pk - xk) * mu[AW + col]; xv += (pvv - xv) * mu[2 * AW + col];
            const float w = w0[col] + lo[col]; const float av = sigmoidf_(a0[col] + lo[AW + col]);
            const float nw = -w; const float sp = fmaxf(nw, 0.f) + log1pf(expf(-fabsf(nw)));
            const float dec = expf(-expf(-sp - 0.5f));
            float kk = xk * k_k[col]; const float n2 = wave_sum(kk * kk); kk = kk / fmaxf(sqrtf(n2), 1e-12f);
            const float kp = xk * (1.0f + (av - 1.0f) * k_a[col]); const float bb = kk * av;
            const float rk = wave_sum(xr * kp * r_k[col]);
            float* rec = SC + sc_record(k, h) * 384;
            rec[lane] = xr; rec[64 + lane] = dec; rec[128 + lane] = kp; rec[192 + lane] = kk; rec[256 + lane] = bb; rec[320 + lane] = xv;
            if (lane == 0) RK[(size_t)row * AH + h] = rk; }
    }
}
__device__ __forceinline__ void e3_items(const Args& a, int l, int first, int step, int lane) {
    unsigned char* ws = a.ws; const float* LOUT = (const float*)(ws + OFF_LOUT); const float* SC = (const float*)(ws + OFF_R1); const float* RK = (const float*)(ws + OFF_RK); const float* ORAW = (const float*)(ws + OFF_ORAW); bf16* YA = (bf16*)(ws + OFF_YA);
    const float* lnw = INP(I_LNW) + l * AW; const float* lnb = INP(I_LNB) + l * AW;
    for (int row = first; row < MT; row += step) {
        const Tok k = tok_of(row);
        for (int h = 0; h < AH; ++h) { const int col = h * 64 + lane;
            const float o = ORAW[(size_t)row * AW + col]; const float mean = wave_sum(o) * (1.0f / 64.0f); const float dv = o - mean; const float var = wave_sum(dv * dv) * (1.0f / 64.0f);
            const float on = dv * (1.0f / sqrtf(var + GN_EPS)) * lnw[col] + lnb[col];
            const float v = SC[sc_record(k, h) * 384 + 320 + lane]; const float rk = ld_agent(RK + (size_t)row * AH + h); const float g = LOUT[(size_t)row * LN3 + 2 * AW + col];
            YA[(size_t)row * AW + col] = (bf16)f2bf((on + rk * v) * g); }
    }
}

__device__ __forceinline__ float dpp_x1(float v) { return __int_as_float(__builtin_amdgcn_update_dpp(0, __float_as_int(v), 0xB1, 0xF, 0xF, true)); }
__device__ __forceinline__ float dpp_x2(float v) { return __int_as_float(__builtin_amdgcn_update_dpp(0, __float_as_int(v), 0x4E, 0xF, 0xF, true)); }
#define SCAN_STEP(LD4, VI, OUT) do { \
    v4f kk_[4], b_[4], d_[4], k_[4], r_[4]; \
    _Pragma("unroll") for (int q_ = 0; q_ < 4; ++q_) { r_[q_] = LD4(0, q_); d_[q_] = LD4(64, q_); k_[q_] = LD4(128, q_); kk_[q_] = LD4(192, q_); b_[q_] = LD4(256, q_); } \
    float sk_ = 0.f; _Pragma("unroll") for (int q_ = 0; q_ < 4; ++q_) sk_ += (S[q_].x * kk_[q_].x + S[q_].y * kk_[q_].y) + (S[q_].z * kk_[q_].z + S[q_].w * kk_[q_].w); \
    sk_ += dpp_x1(sk_); sk_ += dpp_x2(sk_); \
    const float vi_ = (VI); float o_ = 0.f; \
    _Pragma("unroll") for (int q_ = 0; q_ < 4; ++q_) { S[q_] = S[q_] * d_[q_] - b_[q_] * sk_ + k_[q_] * vi_; o_ += (S[q_].x * r_[q_].x + S[q_].y * r_[q_].y) + (S[q_].z * r_[q_].z + S[q_].w * r_[q_].w); } \
    o_ += dpp_x1(o_); o_ += dpp_x2(o_); (OUT) = o_; } while (0)

__device__ __forceinline__ void scan_phase(const Args& a, int l, LAS unsigned char* lds, int vcu, int G, int wave, int lane) {
    unsigned char* ws = a.ws; const float* SC = (const float*)(ws + OFF_R1); float* ORAW = (float*)(ws + OFF_ORAW);
    const int ri = lane >> 2, jq = lane & 3;
    if (wave == 0) {
        for (int task = vcu; task < NBATCH * AH * 4; task += G) {
            const int bh = task >> 2, rq = task & 3, i = 16 * rq + ri, b = bh >> 4, h = bh & 15;
            const char* src = (const char*)(SC + (size_t)bh * SEQ * 384);
            v4f S[4]; S[0] = S[1] = S[2] = S[3] = (v4f){0.f, 0.f, 0.f, 0.f};
            constexpr int NBLK = SEQ / 2, NSLOT = 8, BLKB = 3072;
#define SCAN_ISSUE(blk) do { const char* g_ = src + (size_t)(blk) * BLKB + lane * 16; const unsigned so_ = (unsigned)((blk) & (NSLOT - 1)) * BLKB; \
            _Pragma("unroll") for (int i_ = 0; i_ < 3; ++i_) __builtin_amdgcn_global_load_lds((const unsigned*)(g_ + i_ * 1024), (LAS unsigned*)(lds + so_ + i_ * 1024), 16, 0, 0); } while (0)
            for (int blk = 0; blk < NSLOT; ++blk) SCAN_ISSUE(blk);
            float* op = ORAW + ((size_t)b * SEQ) * AW + h * 64 + i;
            for (int blk = 0; blk < NBLK; ++blk) {
                if (blk < NBLK - (NSLOT - 1)) asm volatile("s_waitcnt vmcnt(21)" ::: "memory"); else asm volatile("s_waitcnt vmcnt(0)" ::: "memory");
                const LAS float* slot = (const LAS float*)(lds + (unsigned)(blk & (NSLOT - 1)) * BLKB);
#pragma unroll
                for (int st = 0; st < 2; ++st) { const LAS float* p = slot + st * 384; float o;
#define LD4_LDS(off, q) (*(const LAS v4f*)(p + (off) + 16 * jq + 4 * (q)))
                    SCAN_STEP(LD4_LDS, p[320 + i], o);
#undef LD4_LDS
                    if (jq == 0) op[(size_t)(2 * blk + st) * AW] = o; }
                asm volatile("s_waitcnt lgkmcnt(0)" ::: "memory");
                if (blk + NSLOT < NBLK) SCAN_ISSUE(blk + NSLOT);
            }
#undef SCAN_ISSUE
            asm volatile("s_waitcnt vmcnt(0)" ::: "memory");
            float* so = a.out + OUT_WKP + (((size_t)(l * NBATCH + b) * AH + h) * AN + i) * AN + 16 * jq;
#pragma unroll
            for (int q = 0; q < 4; ++q) *(v4f*)(so + 4 * q) = S[q];
        }
    } else {
        const int sw = vcu * (NWAVES - 1) + (wave - 1), NSW = G * (NWAVES - 1);
        for (int task = sw; task < DBATCH * AH * 4; task += NSW) {
            const int bh = task >> 2, rq = task & 3, i = 16 * rq + ri, b = bh >> 4, h = bh & 15;
            const size_t sidx = (((size_t)(l * DBATCH + b) * AH + h) * AN + i) * AN + 16 * jq;
            const float* sp = INP(I_SWKV) + sidx; v4f S[4];
#pragma unroll
            for (int q = 0; q < 4; ++q) S[q] = *(const v4f*)(sp + 4 * q);
            const float* rec = SC + ((size_t)NBATCH * AH * SEQ + (size_t)bh * DSEQ) * 384;
            float* op = ORAW + ((size_t)MP + b * DSEQ) * AW + h * 64 + i;
#pragma unroll
            for (int st = 0; st < DSEQ; ++st) { const float* p = rec + st * 384; float o;
#define LD4_G(off, q) (*(const v4f*)(p + (off) + 16 * jq + 4 * (q)))
                SCAN_STEP(LD4_G, p[320 + i], o);
#undef LD4_G
                if (jq == 0) op[(size_t)st * AW] = o; }
            float* so = a.out + OUT_WKS + sidx;
#pragma unroll
            for (int q = 0; q < 4; ++q) *(v4f*)(so + 4 * q) = S[q];
        }
    }
}

__device__ __forceinline__ void attn_phase(const Args& a, int l, LAS unsigned char* lds, int gw, int NGW, int wave, int lane) {
    unsigned char* ws = a.ws; const bf16* PB = (const bf16*)(ws + OFF_PB); bf16* YB = (bf16*)(ws + OFF_YB);
    LAS bf16* Vt = (LAS bf16*)(lds + wave * 8192);
    LAS float* linv = (LAS float*)(lds + wave * 8192 + 4096);
    LAS float* pbuf = (LAS float*)(lds + wave * 8192 + 4096 + 256);
    const int c31 = lane & 31, hh = lane >> 5;
    const float* sinks = INP(I_SINK) + l * AH;
    for (int item = gw; item < NBATCH * AH * (SEQ / 32); item += NGW) {
        const int b = item >> 10, h = (item >> 6) & 15, qb = item & 63, kvh = h >> 2, q0 = qb * 32, rowbase = b * SEQ;
        v8s qf[4]; { const bf16* qp = PB + (size_t)(rowbase + q0 + c31) * BPROJ + h * 64 + 8 * hh;
#pragma unroll
            for (int s = 0; s < 4; ++s) qf[s] = *(const v8s*)(qp + 16 * s); }
        v16f S[5]; float mx = -INFINITY;
#pragma unroll
        for (int tile = 0; tile < 5; ++tile) { const int kt0 = q0 - WIN + 32 * tile;
            if (kt0 < 0) {
#pragma unroll
                for (int r = 0; r < 16; ++r) S[tile][r] = -INFINITY;
            } else {
                const bf16* kp = PB + (size_t)(rowbase + kt0 + c31) * BPROJ + QW + kvh * 64 + 8 * hh; v16f acc;
#pragma unroll
                for (int r = 0; r < 16; ++r) acc[r] = 0.f;
#pragma unroll
                for (int s = 0; s < 4; ++s) { const v8s kf = *(const v8s*)(kp + 16 * s); acc = __builtin_amdgcn_mfma_f32_32x32x16_bf16(kf, qf[s], acc, 0, 0, 0); }
#pragma unroll
                for (int r = 0; r < 16; ++r) { const int key = kt0 + (r & 3) + 8 * (r >> 2) + 4 * hh; const int diff = q0 + c31 - key; const bool ok = diff >= 0 && diff < WIN;
                    const float s = ok ? acc[r] * 0.125f : -INFINITY; S[tile][r] = s; mx = fmaxf(mx, s); }
            } }
        mx = fmaxf(mx, __shfl_xor(mx, 32)); const float sink = sinks[h]; mx = fmaxf(mx, sink);
        float sum = 0.f;
#pragma unroll
        for (int tile = 0; tile < 5; ++tile)
#pragma unroll
            for (int r = 0; r < 16; ++r) { const float p = __expf(S[tile][r] - mx); S[tile][r] = p; sum += p; }
        sum += __shfl_xor(sum, 32); sum += __expf(sink - mx);
        if (lane < 32) linv[lane] = 1.0f / sum;
        v16f O0, O1;
#pragma unroll
        for (int r = 0; r < 16; ++r) { O0[r] = 0.f; O1[r] = 0.f; }
#pragma unroll
        for (int tile = 0; tile < 5; ++tile) { const int kt0 = q0 - WIN + 32 * tile;
            if (kt0 >= 0) {
#pragma unroll
                for (int i = 0; i < 4; ++i) { const int idx = i * 64 + lane, key = idx >> 3, ch = idx & 7;
                    *(LAS v4u*)(Vt + key * 64 + ch * 8) = *(const v4u*)(PB + (size_t)(rowbase + kt0 + key) * BPROJ + QW + KVW + kvh * 64 + ch * 8); }
#pragma unroll
                for (int s = 0; s < 2; ++s) { v8s pf;
#pragma unroll
                    for (int j = 0; j < 8; j += 2) { const unsigned w = pk2(S[tile][8 * s + j], S[tile][8 * s + j + 1]); pf[j] = (short)(w & 0xffffu); pf[j + 1] = (short)(w >> 16); }
                    v8s v0, v1;
#pragma unroll
                    for (int j = 0; j < 8; ++j) { const int key = 16 * s + 8 * (j >> 2) + 4 * hh + (j & 3); v0[j] = (short)Vt[key * 64 + c31]; v1[j] = (short)Vt[key * 64 + 32 + c31]; }
                    O0 = __builtin_amdgcn_mfma_f32_32x32x16_bf16(pf, v0, O0, 0, 0, 0); O1 = __builtin_amdgcn_mfma_f32_32x32x16_bf16(pf, v1, O1, 0, 0, 0); }
            } }
#pragma unroll
        for (int r = 0; r < 16; ++r) { const int q = (r & 3) + 8 * (r >> 2) + 4 * hh; const float li = linv[q]; bf16* yp = YB + (size_t)(rowbase + q0 + q) * QW + h * 64 + c31;
            yp[0] = (bf16)f2bf(O0[r] * li); yp[32] = (bf16)f2bf(O1[r] * li); }
    }
    LAS float* qs = pbuf + 132 * 4;
    for (int item = gw; item < DBATCH * AH; item += NGW) {
        const int b = item >> 4, h = item & 15, kvh = h >> 2; const int row0 = MP + b * DSEQ;
        const float* ck = INP(I_CK) + (((size_t)l * DBATCH + b) * WIN) * KVW + kvh * 64; const float* cv = INP(I_CV) + (((size_t)l * DBATCH + b) * WIN) * KVW + kvh * 64;
#pragma unroll
        for (int t = 0; t < 4; ++t) qs[t * 64 + lane] = bf2f(PB[(size_t)(row0 + t) * BPROJ + h * 64 + lane]);
        float s0[4] = {0.f, 0.f, 0.f, 0.f}, s1[4] = {0.f, 0.f, 0.f, 0.f}, s2[4] = {0.f, 0.f, 0.f, 0.f};
        const float* k0p = ck + (size_t)lane * KVW; const float* k1p = ck + (size_t)(lane + 64) * KVW; const bf16* k2p = PB + (size_t)(row0 + (lane & 3)) * BPROJ + QW + kvh * 64;
        for (int d = 0; d < 64; d += 4) { const v4f ka = *(const v4f*)(k0p + d), kb = *(const v4f*)(k1p + d); const v2u kc = *(const v2u*)(k2p + d); const float c0 = bflo(kc.x), c1 = bfhi(kc.x), c2 = bflo(kc.y), c3 = bfhi(kc.y);
#pragma unroll
            for (int t = 0; t < 4; ++t) { const v4f q = *(const LAS v4f*)(qs + t * 64 + d);
                s0[t] += (ka.x * q.x + ka.y * q.y) + (ka.z * q.z + ka.w * q.w); s1[t] += (kb.x * q.x + kb.y * q.y) + (kb.z * q.z + kb.w * q.w); s2[t] += (c0 * q.x + c1 * q.y) + (c2 * q.z + c3 * q.w); } }
        const float sink = sinks[h];
#pragma unroll
        for (int t = 0; t < 4; ++t) {
            const float a0 = (lane >= t + 1) ? s0[t] * 0.125f : -INFINITY;
            const float a1 = s1[t] * 0.125f;
            const float a2 = (lane < 4 && lane <= t) ? s2[t] * 0.125f : -INFINITY;
            const float m = fmaxf(wave_max(fmaxf(fmaxf(a0, a1), a2)), sink);
            const float p0 = __expf(a0 - m), p1 = __expf(a1 - m), p2 = __expf(a2 - m);
            const float inv = 1.0f / (wave_sum(p0 + p1 + p2) + __expf(sink - m));
            pbuf[lane * 4 + t] = p0 * inv; pbuf[(lane + 64) * 4 + t] = p1 * inv; if (lane < 4) pbuf[(128 + lane) * 4 + t] = p2 * inv; }
        float o[4] = {0.f, 0.f, 0.f, 0.f};
        for (int key = 0; key < WIN; ++key) { const float v = cv[(size_t)key * KVW + lane]; const v4f p = *(const LAS v4f*)(pbuf + key * 4); o[0] += p.x * v; o[1] += p.y * v; o[2] += p.z * v; o[3] += p.w * v; }
#pragma unroll
        for (int t2 = 0; t2 < 4; ++t2) { const float v = bf2f(PB[(size_t)(row0 + t2) * BPROJ + QW + KVW + kvh * 64 + lane]); const v4f p = *(const LAS v4f*)(pbuf + (128 + t2) * 4); o[0] += p.x * v; o[1] += p.y * v; o[2] += p.z * v; o[3] += p.w * v; }
#pragma unroll
        for (int t = 0; t < 4; ++t) YB[(size_t)(row0 + t) * QW + h * 64 + lane] = (bf16)f2bf(o[t]);
    }
    for (int item = gw; item < NSEQ * WIN; item += NGW) { const int sq = item >> 7, w = item & (WIN - 1);
        if (sq < NBATCH) { const bf16* src = PB + (size_t)(sq * SEQ + SEQ - WIN + w) * BPROJ + QW + lane * 4;
            const v2u kx = *(const v2u*)src, vx = *(const v2u*)(src + KVW);
            *(v4f*)(a.out + OUT_KP + (((size_t)l * NBATCH + sq) * WIN + w) * KVW + lane * 4) = (v4f){bflo(kx.x), bfhi(kx.x), bflo(kx.y), bfhi(kx.y)};
            *(v4f*)(a.out + OUT_VP + (((size_t)l * NBATCH + sq) * WIN + w) * KVW + lane * 4) = (v4f){bflo(vx.x), bfhi(vx.x), bflo(vx.y), bfhi(vx.y)}; }
        else { const int b = sq - NBATCH; v4f kx, vx;
            if (w < WIN - DSEQ) { kx = *(const v4f*)(INP(I_CK) + (((size_t)l * DBATCH + b) * WIN + w + DSEQ) * KVW + lane * 4); vx = *(const v4f*)(INP(I_CV) + (((size_t)l * DBATCH + b) * WIN + w + DSEQ) * KVW + lane * 4); }
            else { const bf16* src = PB + (size_t)(MP + b * DSEQ + (w - (WIN - DSEQ))) * BPROJ + QW + lane * 4; const v2u k2 = *(const v2u*)src, v2 = *(const v2u*)(src + KVW);
                kx = (v4f){bflo(k2.x), bfhi(k2.x), bflo(k2.y), bfhi(k2.y)}; vx = (v4f){bflo(v2.x), bfhi(v2.x), bflo(v2.y), bfhi(v2.y)}; }
            *(v4f*)(a.out + OUT_KS + (((size_t)l * DBATCH + b) * WIN + w) * KVW + lane * 4) = kx;
            *(v4f*)(a.out + OUT_VS + (((size_t)l * DBATCH + b) * WIN + w) * KVW + lane * 4) = vx; }
    }
}

namespace mix {
using pg8::sigm_e; using pg8::f32x2_t; using pg8::bf16x2_t;
constexpr int CH = 32;
constexpr int NSEG = 4, SEGLEN = SEQ / NSEG, SEGCH = SEGLEN / CH;
constexpr int L_LIN = 0;
constexpr int L_LO = 18944;
constexpr int L_KR = 0;
constexpr int L_BK = L_KR + 9216;
constexpr int L_VW = L_BK + 9216;
constexpr int L_A2 = L_VW + 9216;
constexpr int L_MKK = L_A2 + 9216;
constexpr int L_MRB = L_MKK + 2560;
constexpr int L_LT = L_MRB + 4608;
constexpr int L_YK = L_LT + 4608;
constexpr int L_Y1 = L_YK + 8320;
constexpr int L_W1F = L_Y1 + 8320;
constexpr int L_W2T = L_W1F + 8320;
constexpr int L_W2P = L_W2T + 5120;
constexpr int L_RTP = L_W2P + 4608;
constexpr int L_EG = L_RTP + 4608;
constexpr int L_PS = L_EG + 256;
constexpr int L_RAW = L_PS + 2048;
constexpr int RAWW = 480;
constexpr int L_END = L_RAW + 33 * RAWW * 4;
static_assert(L_LO + 3 * 32 * 65 * 4 <= L_EG && L_END <= LDSCTL_OFF, "MIX-A LDS map");
#define MIX_BAR() asm volatile("s_waitcnt lgkmcnt(0)\n\ts_barrier" ::: "memory")
__device__ __forceinline__ v4f mfma16(v8s a, v8s b, v4f c) { return __builtin_amdgcn_mfma_f32_16x16x32_bf16(a, b, c, 0, 0, 0); }
__device__ __forceinline__ bf16 bf1(float x) { return __builtin_bit_cast(unsigned short, (__bf16)x); }
__device__ __forceinline__ unsigned pkbf(float lo, float hi) { const f32x2_t v = {lo, hi}; const bf16x2_t b = __builtin_convertvector(v, bf16x2_t); return __builtin_bit_cast(unsigned, b); }
__device__ __forceinline__ int fpos(int idx) { return 8 * ((idx & 15) >> 2) + 4 * ((idx >> 4) & 1) + (idx & 3) + (idx & ~31); }
__device__ __forceinline__ float tanh_e(float x) { return 1.0f - 2.0f * __builtin_amdgcn_rcpf(__expf(2.0f * x) + 1.0f); }

template <int T0> __device__ __forceinline__ void fsub_blk(LAS float* XS, const LAS float* LT, int lane) {
    if constexpr (T0 < 32) {
        float acc[4];
#pragma unroll
        for (int e = 0; e < 4; ++e) acc[e] = XS[(T0 + e) * 65 + lane];
#pragma unroll
        for (int g = 0; g < T0 / 4; ++g) { float xs[4];
#pragma unroll
            for (int k = 0; k < 4; ++k) xs[k] = XS[(4 * g + k) * 65 + lane];
#pragma unroll
            for (int e = 0; e < 4; ++e) { const v4f l4 = *(const LAS v4f*)(LT + (T0 + e) * 36 + 4 * g); acc[e] = __builtin_fmaf(-l4.x, xs[0], acc[e]); acc[e] = __builtin_fmaf(-l4.y, xs[1], acc[e]); acc[e] = __builtin_fmaf(-l4.z, xs[2], acc[e]); acc[e] = __builtin_fmaf(-l4.w, xs[3], acc[e]); } }
        const v4f t1 = *(const LAS v4f*)(LT + (T0 + 1) * 36 + T0), t2 = *(const LAS v4f*)(LT + (T0 + 2) * 36 + T0), t3 = *(const LAS v4f*)(LT + (T0 + 3) * 36 + T0);
        const float x0 = acc[0], x1 = acc[1] - t1.x * x0, x2 = acc[2] - t2.x * x0 - t2.y * x1, x3 = acc[3] - t3.x * x0 - t3.y * x1 - t3.z * x2;
        XS[T0 * 65 + lane] = x0; XS[(T0 + 1) * 65 + lane] = x1; XS[(T0 + 2) * 65 + lane] = x2; XS[(T0 + 3) * 65 + lane] = x3;
        fsub_blk<T0 + 4>(XS, LT, lane);
    }
}

__device__ __forceinline__ size_t o0_frag(int row, int h, int nt) { return ((size_t)((row >> 4) * AH + h) * 4 + nt) * 256; }

struct Job { int row0, nchunks, nvalid, h, l; const float* prev0; const float* state_in; float* state_out; int seg_slot; };

template <int MODE>
__device__ __forceinline__ void run_job(const Args& a, const Job jb_, LAS unsigned char* lds, int tid) {
    constexpr bool FULL = MODE == 0, SAMPLE = MODE == 1;
    unsigned char* ws = a.ws; const float* PA = (const float*)(ws + OFF_PA);
    const int lane = tid & 63, wave = __builtin_amdgcn_readfirstlane(tid >> 6), q = lane >> 4, c16 = lane & 15;
    const int jb = lane, tg = wave;
    const int h = jb_.h, l = jb_.l, col = h * 64 + jb;
    const float* mu = INP(I_MU) + (size_t)l * APROJ;
    const float* cw0 = INP(I_W0) + l * AW; const float* ca0 = INP(I_A0) + l * AW; const float* ckk = INP(I_KK) + l * AW; const float* cka = INP(I_KA) + l * AW; const float* crk = INP(I_RK) + l * AW;
    const int mt = wave >> 2, nt = wave & 3;
    LAS bf16* LIN = (LAS bf16*)(lds + L_LIN); LAS float* LO = (LAS float*)(lds + L_LO); LAS float* PS = (LAS float*)(lds + L_PS);
    constexpr int nvalid = CH; const int b0 = jb_.row0;
    const float* shiftb = SAMPLE ? INP(I_SSH) + (size_t)l * DBATCH * APROJ : nullptr;
    v4f xt[4];
    if (FULL) { const int cs = wave;
#pragma unroll
        for (int jt = 0; jt < 4; ++jt)
#pragma unroll
            for (int r = 0; r < 4; ++r) xt[jt][r] = (cs >= 4 && 16 * jt + 4 * q + r == 16 * (cs - 4) + c16) ? 1.f : 0.f; }
    LAS float* RAW = (LAS float*)(lds + L_RAW);
#define MIX_PREFETCH_DMA(CHN) do { const int rowc_ = SAMPLE ? 0 : jb_.row0 + (CHN) * CH; const float* pa_ = PA + (size_t)rowc_ * APAD; const float* pv_ = ((CHN) == 0) ? jb_.prev0 : pa_ - APAD; \
        _Pragma("unroll 1") for (int k_ = 0; k_ < 8; ++k_) { const int ki_ = wave + 8 * k_; const int p_ = 64 * ki_ + lane; const int row_ = p_ / 120, c4_ = p_ - row_ * 120; \
            const int scol_ = c4_ < 48 ? (c4_ >> 4) * AW + h * 64 + 4 * (c4_ & 15) : 3072 + 4 * (c4_ - 48); \
            const bool act_ = p_ < 33 * 120 && (row_ == 0 ? (!SAMPLE && pv_ != nullptr) : true); const int tl_ = row_ - 1; \
            const float* src_ = (row_ == 0 ? pv_ : (SAMPLE ? PA + (size_t)(MP + 4 * (b0 + 16 * (tl_ >> 2)) + (tl_ & 3)) * APAD : pa_ + (size_t)tl_ * APAD)) + scol_; \
            if (ki_ < 62 && act_) __builtin_amdgcn_global_load_lds((const unsigned*)src_, (LAS unsigned*)(lds + L_RAW + 1024 * ki_), 16, 0, 0); } \
        if (!SAMPLE && pv_ == nullptr && tid < 120) { float z_ = 0.f; asm volatile("" : "+v"(z_)); *(LAS v4f*)(RAW + 4 * tid) = (v4f){z_, z_, z_, z_}; } } while (0)
    MIX_BAR();
    MIX_PREFETCH_DMA(0);
    for (int ch = 0; ch < jb_.nchunks; ++ch) {
        const int rowc = SAMPLE ? 0 : jb_.row0 + ch * CH;
        if (ch == 0) asm volatile("s_waitcnt vmcnt(0)" ::: "memory"); else asm volatile("s_waitcnt vmcnt(16)" ::: "memory");
        MIX_BAR();
#pragma unroll 1
        for (int i = 0; i < 5; ++i) { const int vi = tid + 512 * i;
            if (vi < 2304) { const int t = vi / 72, cv = vi - t * 72; const int tt = t;
                const v4f cur = *(const LAS v4f*)(RAW + (tt + 1) * RAWW + 192 + 4 * cv); v4f prv;
                if (SAMPLE && (t & 3) == 0) prv = *(const v4f*)(shiftb + (size_t)(b0 + 16 * (t >> 2)) * APROJ + 3072 + 4 * cv); else prv = *(const LAS v4f*)(RAW + tt * RAWW + 192 + 4 * cv);
                const v4f m = *(const v4f*)(mu + 3072 + 4 * cv); v4f xm = cur + (prv - cur) * m;
                if (cv < 16) { xm.x = tanh_e(xm.x); xm.y = tanh_e(xm.y); xm.z = tanh_e(xm.z); xm.w = tanh_e(xm.w); }
                else if (cv >= 32) { xm.x = sigm_e(xm.x); xm.y = sigm_e(xm.y); xm.z = sigm_e(xm.z); xm.w = sigm_e(xm.w); }
                v2u w; w.x = pkbf(xm.x, xm.y); w.y = pkbf(xm.z, xm.w); *(LAS v2u*)(LIN + t * 296 + 4 * cv) = w; } }
        int colx = col; asm volatile("" : "+v"(colx));
        const float mu_r = mu[colx], mu_k = mu[AW + colx], mu_v = mu[2 * AW + colx];
        const float w0c = cw0[colx], a0c = ca0[colx], kkc = ckk[colx], kac = cka[colx], rkc = crk[colx];
        float rm[4], km[4], vm[4];
#pragma unroll
        for (int r = 0; r < 4; ++r) { const int tt = 4 * tg + r; const LAS float* cp = RAW + (tt + 1) * RAWW + jb; const LAS float* pp = cp - RAWW; float p0, p1, p2;
            if (SAMPLE && r == 0) { const float* sp = shiftb + (size_t)(b0 + 16 * tg) * APROJ + colx; p0 = sp[0]; p1 = sp[AW]; p2 = sp[2 * AW]; } else { p0 = pp[0]; p1 = pp[64]; p2 = pp[128]; }
            rm[r] = cp[0] + (p0 - cp[0]) * mu_r; km[r] = cp[64] + (p1 - cp[64]) * mu_k; vm[r] = cp[128] + (p2 - cp[128]) * mu_v; }
        MIX_BAR();
        if (ch + 1 < jb_.nchunks) MIX_PREFETCH_DMA(ch + 1);
        {           v8s bw[2], ba[2], bg[5];
          { const bf16* WL = (const bf16*)(ws + OFF_WL + (size_t)l * SZ_WL); const int n = h * 64 + 16 * nt + c16;
#pragma unroll
            for (int ks = 0; ks < 2; ++ks) { bw[ks] = *(const v8s*)(WL + (size_t)n * LK + 32 * ks + 8 * q); ba[ks] = *(const v8s*)(WL + (size_t)(AW + n) * LK + 64 + 32 * ks + 8 * q); }
#pragma unroll
            for (int ks = 0; ks < 5; ++ks) bg[ks] = *(const v8s*)(WL + (size_t)(2 * AW + n) * LK + 128 + 32 * ks + 8 * q); }
          v4f cw = {0.f, 0.f, 0.f, 0.f}, ca = cw, cg = cw; const LAS bf16* ap = LIN + (16 * mt + c16) * 296 + 8 * q;
#pragma unroll
          for (int ks = 0; ks < 2; ++ks) { cw = mfma16(*(const LAS v8s*)(ap + 32 * ks), bw[ks], cw); ca = mfma16(*(const LAS v8s*)(ap + 64 + 32 * ks), ba[ks], ca); }
#pragma unroll
          for (int ks = 0; ks < 5; ++ks) cg = mfma16(*(const LAS v8s*)(ap + 128 + 32 * ks), bg[ks], cg);
#pragma unroll
          for (int r = 0; r < 4; ++r) { const int o = (16 * mt + 4 * q + r) * 65 + 16 * nt + c16; LO[o] = cw[r]; LO[32 * 65 + o] = ca[r]; LO[2 * 32 * 65 + o] = cg[r]; } }
        MIX_BAR();
        float ldv[4], kkn[4], kp[4], bb[4], gv[4], rkv[4];
#pragma unroll
        for (int r = 0; r < 4; ++r) { const int t = 4 * tg + r; const bool ok = t < nvalid;
            const float w = w0c + LO[t * 65 + jb], av = sigm_e(a0c + LO[32 * 65 + t * 65 + jb]); gv[r] = LO[2 * 32 * 65 + t * 65 + jb];
            const float nw = -w; const float sp = fmaxf(nw, 0.f) + __logf(1.0f + __expf(-fabsf(nw)));
            ldv[r] = ok ? -__expf(-sp - 0.5f) : 0.f;
            const float kk = km[r] * kkc; const float n2 = wave_sum(kk * kk); kkn[r] = kk * __builtin_amdgcn_rsqf(fmaxf(n2, 1e-24f));
            const float kpv = km[r] * (1.0f + (av - 1.0f) * kac); rkv[r] = wave_sum(rm[r] * kpv * rkc);
            kp[r] = ok ? kpv : 0.f; bb[r] = ok ? kkn[r] * av : 0.f; if (!ok) vm[r] = 0.f; }
#define MIX_ROW(t_) (SAMPLE ? MP + 4 * (b0 + 16 * ((t_) >> 2)) + ((t_) & 3) : rowc + (t_))
        if (SAMPLE) {
            bf16* GB = (bf16*)(ws + OFF_GB); bf16* BV = (bf16*)(ws + OFF_BV); float* O0 = (float*)(ws + OFF_ORAW); LAS float* REC = RAW;
#pragma unroll
            for (int r = 0; r < 4; ++r) { const int t = 4 * tg + r; const size_t row = MIX_ROW(t); GB[row * AW + col] = bf1(gv[r]); BV[row * AW + col] = bf1(rkv[r] * vm[r]);
                LAS float* rec = REC + t * 384 + jb; rec[0] = rm[r]; rec[64] = __expf(ldv[r]); rec[128] = kp[r]; rec[192] = kkn[r]; rec[256] = bb[r]; rec[320] = vm[r]; }
            MIX_BAR();
            const int ri = lane >> 2, jq = lane & 3;
            for (int task = wave; task < 32; task += NWAVES) { const int k = task >> 2, rq = task & 3, i = 16 * rq + ri; const int b = b0 + 16 * k;
                const size_t sidx = (((size_t)(l * DBATCH + b) * AH + h) * AN + i) * AN + 16 * jq; const float* sp = INP(I_SWKV) + sidx; v4f S[4];
#pragma unroll
                for (int qq = 0; qq < 4; ++qq) S[qq] = *(const v4f*)(sp + 4 * qq);
#pragma unroll
                for (int st = 0; st < DSEQ; ++st) { const LAS float* p = REC + (4 * k + st) * 384; float o;
#define LD4_L(off, qq) (*(const LAS v4f*)(p + (off) + 16 * jq + 4 * (qq)))
                    SCAN_STEP(LD4_L, p[320 + i], o);
#undef LD4_L
                    if (jq == 0) { const int row = MP + 4 * b + st; O0[o0_frag(row, h, i >> 4) + (size_t)(16 * ((row & 15) >> 2) + (i & 15)) * 4 + (row & 3)] = o; } }
                float* so = a.out + OUT_WKS + sidx;
#pragma unroll
                for (int qq = 0; qq < 4; ++qq) *(v4f*)(so + 4 * qq) = S[qq]; }
        }
        if (FULL) {
            bf16* GB = (bf16*)(ws + OFF_GB); bf16* BV = (bf16*)(ws + OFF_BV); float* O0 = (float*)(ws + OFF_ORAW); float* RHO = (float*)(ws + OFF_RHO);
            LAS bf16* KR = (LAS bf16*)(lds + L_KR); LAS bf16* BK = (LAS bf16*)(lds + L_BK); LAS bf16* VW = (LAS bf16*)(lds + L_VW); LAS bf16* A2 = (LAS bf16*)(lds + L_A2);
            LAS bf16* MKK = (LAS bf16*)(lds + L_MKK); LAS bf16* MRB = (LAS bf16*)(lds + L_MRB); LAS float* LT = (LAS float*)(lds + L_LT); LAS float* YK = (LAS float*)(lds + L_YK);
            LAS float* EG = (LAS float*)(lds + L_EG); LAS float* Y1 = (LAS float*)(lds + L_Y1); LAS float* W1F = (LAS float*)(lds + L_W1F);
            LAS bf16* W2T = (LAS bf16*)(lds + L_W2T); LAS bf16* W2P = (LAS bf16*)(lds + L_W2P); LAS bf16* RTP = (LAS bf16*)(lds + L_RTP);
#pragma unroll
            for (int r = 0; r < 4; ++r) { const int t = 4 * tg + r; if (t < nvalid) { GB[(size_t)(rowc + t) * AW + col] = bf1(gv[r]); BV[(size_t)(rowc + t) * AW + col] = bf1(rkv[r] * vm[r]); } }
            const float c0 = ldv[0], c1 = c0 + ldv[1], c2 = c1 + ldv[2], c3 = c2 + ldv[3];
            PS[tg * 64 + jb] = c3;
            MIX_BAR();
            { float off = 0.f, tot = 0.f;
#pragma unroll
              for (int w = 0; w < 8; ++w) { const float p = PS[w * 64 + jb]; tot += p; off += (w < tg) ? p : 0.f; }
              const float gc[4] = {off + c0, off + c1, off + c2, off + c3};
              float eG[4], eGm1[4];
#pragma unroll
              for (int r = 0; r < 4; ++r) eG[r] = __expf(gc[r]);
              eGm1[0] = __expf(off); eGm1[1] = eG[0]; eGm1[2] = eG[1]; eGm1[3] = eG[2];
              const float eT = __expf(tot);
              float ktv[4], btv[4];
#pragma unroll
              for (int r = 0; r < 4; ++r) { const int t = 4 * tg + r; const float inv = __builtin_amdgcn_rcpf(eG[r]); const float kh = kkn[r] * eGm1[r];
                  KR[t * 72 + jb] = bf1(kh); KR[(32 + t) * 72 + jb] = bf1(rm[r] * eG[r]); BK[t * 72 + jb] = bf1(bb[r] * inv); BK[(32 + t) * 72 + jb] = bf1(kp[r] * inv);
                  YK[t * 65 + jb] = kh; ktv[r] = kp[r] * (eT * inv); btv[r] = bb[r] * (eT * inv); }
              v2u w; w.x = pkbf(vm[0], vm[1]); w.y = pkbf(vm[2], vm[3]); *(LAS v2u*)(VW + jb * 72 + 4 * tg) = w;
              w.x = pkbf(ktv[0], ktv[1]); w.y = pkbf(ktv[2], ktv[3]); *(LAS v2u*)(A2 + jb * 72 + 4 * tg) = w;
              w.x = pkbf(btv[0], btv[1]); w.y = pkbf(btv[2], btv[3]); *(LAS v2u*)(A2 + jb * 72 + 32 + 8 * (tg & 3) + 4 * (tg >> 2)) = w;
              if (tg == 0) EG[jb] = eT; }
            MIX_BAR();
            { const int mt4 = wave >> 1, ntp = wave & 1; v4f m0 = {0.f, 0.f, 0.f, 0.f}, m1 = m0;
#pragma unroll
              for (int ks = 0; ks < 2; ++ks) { const v8s af = *(const LAS v8s*)(KR + (16 * mt4 + c16) * 72 + 32 * ks + 8 * q);
                  m0 = mfma16(af, *(const LAS v8s*)(BK + (32 * ntp + c16) * 72 + 32 * ks + 8 * q), m0); m1 = mfma16(af, *(const LAS v8s*)(BK + (32 * ntp + 16 + c16) * 72 + 32 * ks + 8 * q), m1); }
#pragma unroll
              for (int tile = 0; tile < 2; ++tile)
#pragma unroll
                  for (int r = 0; r < 4; ++r) { const float val = tile ? m1[r] : m0[r]; const int t = (16 * mt4 + 4 * q + r) & 31, s = 16 * tile + c16;
                      if (mt4 < 2) { if (ntp == 0) LT[t * 36 + s] = (s < t) ? val : 0.f; else MKK[t * 40 + s] = bf1((s < t) ? val : 0.f); }
                      else { if (ntp == 0) MRB[t * 72 + 32 + s] = bf1((s <= t) ? -val : 0.f); else MRB[t * 72 + s] = bf1((s <= t) ? val : 0.f); } } }
            MIX_BAR();
            { v4f y = {0.f, 0.f, 0.f, 0.f}; y = mfma16(*(const LAS v8s*)(MKK + (16 * mt + c16) * 40 + 8 * q), *(const LAS v8s*)(VW + (16 * nt + c16) * 72 + 8 * q), y);
#pragma unroll
              for (int r = 0; r < 4; ++r) Y1[(16 * mt + 4 * q + r) * 65 + 16 * nt + c16] = y[r]; }
            MIX_BAR();
            if (wave < 2) { LAS float* XS = wave == 0 ? YK : Y1;
#ifndef NO_FSUB
                fsub_blk<0>(XS, LT, lane);
#endif
                if (wave == 0) { const int pj = fpos(lane);
#pragma unroll
                    for (int t8 = 0; t8 < 32; t8 += 8) { float x[8];
#pragma unroll
                        for (int e = 0; e < 8; ++e) x[e] = XS[(t8 + e) * 65 + lane];
                        v4u w; w.x = pkbf(x[0], x[1]); w.y = pkbf(x[2], x[3]); w.z = pkbf(x[4], x[5]); w.w = pkbf(x[6], x[7]); *(LAS v4u*)(W2T + lane * 40 + t8) = w;
#pragma unroll
                        for (int e = 0; e < 8; ++e) W2P[(t8 + e) * 72 + pj] = bf1(x[e]); }
                } else {
#pragma unroll
                    for (int t8 = 0; t8 < 32; t8 += 8) { float x[8];
#pragma unroll
                        for (int e = 0; e < 8; ++e) x[e] = XS[(t8 + e) * 65 + lane];
                        v4u w; w.x = pkbf(x[0], x[1]); w.y = pkbf(x[2], x[3]); w.z = pkbf(x[4], x[5]); w.w = pkbf(x[6], x[7]); *(LAS v4u*)(VW + lane * 72 + 32 + t8) = w;
#pragma unroll
                        for (int e = 0; e < 8; ++e) W1F[(t8 + e) * 65 + lane] = x[e]; }
                } }
            MIX_BAR();
            { v4f c;
#pragma unroll
              for (int r = 0; r < 4; ++r) c[r] = bf2f(KR[(32 + 16 * mt + 4 * q + r) * 72 + 16 * nt + c16]);
              c = mfma16(*(const LAS v8s*)(MRB + (16 * mt + c16) * 72 + 32 + 8 * q), *(const LAS v8s*)(W2T + (16 * nt + c16) * 40 + 8 * q), c);
              const int pj = fpos(16 * nt + c16);
#pragma unroll
              for (int r = 0; r < 4; ++r) RTP[(16 * mt + 4 * q + r) * 72 + pj] = bf1(c[r]); }
            MIX_BAR();
#ifndef MIXDBG_NO8
            { const int cs = wave; v8s xf[2];
#pragma unroll
              for (int ks = 0; ks < 2; ++ks) { v4u w; w.x = pkbf(xt[2 * ks][0], xt[2 * ks][1]); w.y = pkbf(xt[2 * ks][2], xt[2 * ks][3]); w.z = pkbf(xt[2 * ks + 1][0], xt[2 * ks + 1][1]); w.w = pkbf(xt[2 * ks + 1][2], xt[2 * ks + 1][3]); xf[ks] = __builtin_bit_cast(v8s, w); }
              v4f wx[2], rx[2], u[2];
#pragma unroll
              for (int m2 = 0; m2 < 2; ++m2) { wx[m2] = (v4f){0.f, 0.f, 0.f, 0.f}; rx[m2] = wx[m2];
#pragma unroll
                  for (int ks = 0; ks < 2; ++ks) { wx[m2] = mfma16(*(const LAS v8s*)(W2P + (16 * m2 + c16) * 72 + 32 * ks + 8 * q), xf[ks], wx[m2]); rx[m2] = mfma16(*(const LAS v8s*)(RTP + (16 * m2 + c16) * 72 + 32 * ks + 8 * q), xf[ks], rx[m2]); } }
              if (cs < 4) {
#pragma unroll
                  for (int m2 = 0; m2 < 2; ++m2) { v4f ol = {0.f, 0.f, 0.f, 0.f};
#pragma unroll
                      for (int ks = 0; ks < 2; ++ks) ol = mfma16(*(const LAS v8s*)(MRB + (16 * m2 + c16) * 72 + 32 * ks + 8 * q), *(const LAS v8s*)(VW + (16 * cs + c16) * 72 + 32 * ks + 8 * q), ol);
#pragma unroll
                      for (int r = 0; r < 4; ++r) { const int t = 16 * m2 + 4 * q + r; ol[r] += rx[m2][r]; u[m2][r] = -wx[m2][r] - W1F[t * 65 + 16 * cs + c16]; }
                      *(v4f*)(O0 + o0_frag(rowc + 16 * m2, h, cs) + (size_t)lane * 4) = ol; }
              } else {
#pragma unroll
                  for (int m2 = 0; m2 < 2; ++m2)
#pragma unroll
                      for (int r = 0; r < 4; ++r) { const int t = 16 * m2 + 4 * q + r; if (jb_.seg_slot >= 0) RHO[(size_t)(rowc + t) * AW + h * 64 + 16 * (cs - 4) + c16] = rx[m2][r]; u[m2][r] = -wx[m2][r]; }
              }
              v8s uf; { v4u w; w.x = pkbf(u[0][0], u[0][1]); w.y = pkbf(u[0][2], u[0][3]); w.z = pkbf(u[1][0], u[1][1]); w.w = pkbf(u[1][2], u[1][3]); uf = __builtin_bit_cast(v8s, w); }
#pragma unroll
              for (int jt = 0; jt < 4; ++jt) { const v4f eg4 = *(const LAS v4f*)(EG + 16 * jt + 4 * q); v4f acc = xt[jt] * eg4;
                  acc = mfma16(*(const LAS v8s*)(A2 + (16 * jt + c16) * 72 + 32 + 8 * q), uf, acc);
                  if (cs < 4) acc = mfma16(*(const LAS v8s*)(A2 + (16 * jt + c16) * 72 + 8 * q), *(const LAS v8s*)(VW + (16 * cs + c16) * 72 + 8 * q), acc);
                  xt[jt] = acc; } }
#endif
        }
    }
    if (FULL) {
        const int cs = wave;
        if (jb_.seg_slot >= 0) { float* dst = (float*)(ws + (cs < 4 ? OFF_SEGX : OFF_SEGP)) + (size_t)jb_.seg_slot * 4096 + 16 * (cs & 3) + c16;
#pragma unroll
            for (int jt = 0; jt < 4; ++jt)
#pragma unroll
                for (int r = 0; r < 4; ++r) dst[(16 * jt + 4 * q + r) * 64] = xt[jt][r];
        }
    }
}

template <bool FULL>
__device__ __forceinline__ void mixa_phase(const Args& a, int l, LAS unsigned char* lds, int vcu, int G, int tid) {
    for (int j = vcu; j < NBATCH * AH * NSEG; j += G) { const int b = j >> 6, h = (j >> 2) & 15, seg = j & 3; Job jb; jb.l = l;
        jb.row0 = b * SEQ + seg * SEGLEN; jb.nchunks = SEGCH; jb.nvalid = CH; jb.h = h; jb.prev0 = seg == 0 ? nullptr : (const float*)(a.ws + OFF_PA) + (size_t)(jb.row0 - 1) * APAD; jb.state_in = nullptr; jb.state_out = nullptr; jb.seg_slot = j;
        run_job<0>(a, jb, lds, tid); }
    for (int j = vcu; j < 16 * AH; j += G) { Job jb; jb.l = l; jb.row0 = j >> 4; jb.nchunks = 1; jb.nvalid = CH; jb.h = j & 15; jb.prev0 = nullptr; jb.state_in = nullptr; jb.state_out = nullptr; jb.seg_slot = -1;
        run_job<1>(a, jb, lds, tid); }
}

__device__ __forceinline__ void gn_tile(const Args& a, int l, int rowt, int h, v4f (&acc)[4], int q, int c16) {
    unsigned char* ws = a.ws; const bf16* GB = (const bf16*)(ws + OFF_GB); const bf16* BV = (const bf16*)(ws + OFF_BV); bf16* YA = (bf16*)(ws + OFF_YA);
    const float* lnw = INP(I_LNW) + l * AW + h * 64 + c16; const float* lnb = INP(I_LNB) + l * AW + h * 64 + c16;
#pragma unroll
    for (int r = 0; r < 4; ++r) { float s = (acc[0][r] + acc[1][r]) + (acc[2][r] + acc[3][r]);
        s += WS_DPP(s, 0xB1); s += WS_DPP(s, 0x4E); s += WS_DPP(s, 0x141); s += WS_DPP(s, 0x140);
        const float mean = s * (1.0f / 64.0f); float d[4], v = 0.f;
#pragma unroll
        for (int nt = 0; nt < 4; ++nt) { d[nt] = acc[nt][r] - mean; v += d[nt] * d[nt]; }
        v += WS_DPP(v, 0xB1); v += WS_DPP(v, 0x4E); v += WS_DPP(v, 0x141); v += WS_DPP(v, 0x140);
        const float rstd = 1.0f / sqrtf(v * (1.0f / 64.0f) + GN_EPS);
        const size_t ro = (size_t)(rowt + 4 * q + r) * AW + h * 64 + c16;
#pragma unroll
        for (int nt = 0; nt < 4; ++nt) { const float y = (d[nt] * rstd * lnw[16 * nt] + lnb[16 * nt] + bf2f(BV[ro + 16 * nt])) * bf2f(GB[ro + 16 * nt]); YA[ro + 16 * nt] = bf1(y); } }
}
__device__ __forceinline__ void mixb_phase(const Args& a, int l, LAS unsigned char* lds, int vcu, int G, int tid) {
    unsigned char* ws = a.ws; const float* O0 = (const float*)(ws + OFF_ORAW); const float* RHO = (const float*)(ws + OFF_RHO);
    const float* SEGX = (const float*)(ws + OFF_SEGX); const float* SEGP = (const float*)(ws + OFF_SEGP);
    const int lane = tid & 63, wave = __builtin_amdgcn_readfirstlane(tid >> 6), q = lane >> 4, c16 = lane & 15;
    LAS float* P = (LAS float*)lds;
    LAS float* Ya = (LAS float*)(lds + 16640);
    LAS float* Yb = (LAS float*)(lds + 16640 + 16384);
    LAS bf16* SB = (LAS bf16*)(lds + 16640 + 32768);
    const int mj = tid >> 3, mi = (tid & 7) * 8;
    for (int j = vcu; j < NBATCH * AH * NSEG; j += G) { const int b = j >> 6, h = (j >> 2) & 15, seg = j & 3; const int row0 = b * SEQ + seg * SEGLEN; const int j0 = j - seg;
        asm volatile("s_waitcnt lgkmcnt(0)\n\ts_barrier" ::: "memory");
        if (seg > 0) {
#pragma unroll
            for (int e = 0; e < 8; ++e) Ya[mj * 64 + mi + e] = SEGX[(size_t)j0 * 4096 + mj * 64 + mi + e];
            LAS float* cur = Ya; LAS float* nxt = Yb;
            const int nmul = (seg == 3) ? 3 : seg - 1;
            for (int s = 1; s <= nmul; ++s) {
                if (s == seg) {
                }
#pragma unroll
                for (int e = 0; e < 8; ++e) P[mj * 65 + mi + e] = SEGP[(size_t)(j0 + s) * 4096 + mj * 64 + mi + e];
                float acc[8];
#pragma unroll
                for (int e = 0; e < 8; ++e) acc[e] = SEGX[(size_t)(j0 + s) * 4096 + mj * 64 + mi + e];
                asm volatile("s_waitcnt lgkmcnt(0)\n\ts_barrier" ::: "memory");
                for (int m = 0; m < 64; ++m) { const float p = P[mj * 65 + m]; const v4f y0 = *(const LAS v4f*)(cur + m * 64 + mi), y1 = *(const LAS v4f*)(cur + m * 64 + mi + 4);
                    acc[0] += p * y0.x; acc[1] += p * y0.y; acc[2] += p * y0.z; acc[3] += p * y0.w; acc[4] += p * y1.x; acc[5] += p * y1.y; acc[6] += p * y1.z; acc[7] += p * y1.w; }
                if (s < seg) {
#pragma unroll
                    for (int e = 0; e < 8; ++e) nxt[mj * 64 + mi + e] = acc[e];
                    asm volatile("s_waitcnt lgkmcnt(0)\n\ts_barrier" ::: "memory");
                    LAS float* t_ = cur; cur = nxt; nxt = t_;
                } else {
                    float* dst = a.out + OUT_WKP + ((size_t)(l * NBATCH + b) * AH + h) * AN * AN;
#pragma unroll
                    for (int e = 0; e < 8; ++e) dst[(size_t)(mi + e) * 64 + mj] = acc[e];
                    asm volatile("s_waitcnt lgkmcnt(0)\n\ts_barrier" ::: "memory");
                }
            }
            asm volatile("s_waitcnt lgkmcnt(0)\n\ts_barrier" ::: "memory");
#pragma unroll
            for (int e = 0; e < 8; ++e) SB[(mi + e) * 72 + mj] = bf1(cur[mj * 64 + mi + e]);
            asm volatile("s_waitcnt lgkmcnt(0)\n\ts_barrier" ::: "memory");
        }
        for (int tt = wave; tt < SEGLEN / 16; tt += NWAVES) { const int rowt = row0 + 16 * tt; v4f acc[4];
#pragma unroll
            for (int nt = 0; nt < 4; ++nt) acc[nt] = *(const v4f*)(O0 + o0_frag(rowt, h, nt) + (size_t)lane * 4);
            if (seg > 0) { v8s af[2];
#pragma unroll
                for (int ks = 0; ks < 2; ++ks) { const float* rp = RHO + (size_t)(rowt + c16) * AW + h * 64 + 32 * ks + 8 * q; const v4f r0 = *(const v4f*)rp, r1 = *(const v4f*)(rp + 4);
                    v4u w; w.x = pkbf(r0.x, r0.y); w.y = pkbf(r0.z, r0.w); w.z = pkbf(r1.x, r1.y); w.w = pkbf(r1.z, r1.w); af[ks] = __builtin_bit_cast(v8s, w); }
#pragma unroll
                for (int nt = 0; nt < 4; ++nt)
#pragma unroll
                    for (int ks = 0; ks < 2; ++ks) acc[nt] = mfma16(af[ks], *(const LAS v8s*)(SB + (16 * nt + c16) * 72 + 32 * ks + 8 * q), acc[nt]); }
            gn_tile(a, l, rowt, h, acc, q, c16);
        }
    }
    for (int it = vcu * NWAVES + wave; it < (MS / 16) * AH; it += G * NWAVES) { const int tt = it >> 4, h = it & 15; const int rowt = MP + 16 * tt; v4f acc[4];
#pragma unroll
        for (int nt = 0; nt < 4; ++nt) acc[nt] = *(const v4f*)(O0 + o0_frag(rowt, h, nt) + (size_t)lane * 4);
        gn_tile(a, l, rowt, h, acc, q, c16);
    }
    asm volatile("s_waitcnt lgkmcnt(0)\n\ts_barrier" ::: "memory");
}

__device__ __forceinline__ void mini_branch(const Args& a, int l, int vcu, int G, int tid) {
    unsigned char* ws = a.ws; const bf16* YA = (const bf16*)(ws + OFF_YA); const bf16* YB = (const bf16*)(ws + OFF_YB); const bf16* WA = (const bf16*)(ws + OFF_WA + (size_t)l * SZ_WAB); const bf16* WB = (const bf16*)(ws + OFF_WB + (size_t)l * SZ_WAB);
    const bf16* Gt = (const bf16*)(ws + OFF_G); bf16* MRG = (bf16*)(ws + OFF_MRG);
    const int lane = tid & 63, wave = __builtin_amdgcn_readfirstlane(tid >> 6), q = lane >> 4, c16 = lane & 15;
    for (int tile = vcu; tile < (MS / 32) * (DM / 128); tile += G) { const int rg = tile >> 4, cg = tile & 15; const int row0 = MP + 32 * rg, colw = cg * 128 + 16 * wave;
        const bf16* pa0 = YA + (size_t)(row0 + c16) * AW + 8 * q; const bf16* pb0 = YB + (size_t)(row0 + c16) * AW + 8 * q;
        const bf16* pwa = WA + (size_t)(colw + c16) * AW + 8 * q; const bf16* pwb = WB + (size_t)(colw + c16) * AW + 8 * q;
        v4f acc[2][2];
#pragma unroll
        for (int p = 0; p < 2; ++p)
#pragma unroll
            for (int mt = 0; mt < 2; ++mt) acc[p][mt] = (v4f){0.f, 0.f, 0.f, 0.f};
#pragma unroll 2
        for (int k4 = 0; k4 < AW / 32; k4 += 4) { v8s fa[4][2], fb[4][2], wa[4], wb[4];
#pragma unroll
            for (int u = 0; u < 4; ++u) { const int ko = 32 * (k4 + u); fa[u][0] = *(const v8s*)(pa0 + ko); fa[u][1] = *(const v8s*)(pa0 + 16 * AW + ko); fb[u][0] = *(const v8s*)(pb0 + ko); fb[u][1] = *(const v8s*)(pb0 + 16 * AW + ko);
                wa[u] = *(const v8s*)(pwa + ko); wb[u] = *(const v8s*)(pwb + ko); }
#pragma unroll
            for (int u = 0; u < 4; ++u) { acc[0][0] = mfma16(fa[u][0], wa[u], acc[0][0]); acc[0][1] = mfma16(fa[u][1], wa[u], acc[0][1]); acc[1][0] = mfma16(fb[u][0], wb[u], acc[1][0]); acc[1][1] = mfma16(fb[u][1], wb[u], acc[1][1]); } }
#pragma unroll
        for (int mt = 0; mt < 2; ++mt)
#pragma unroll
            for (int r = 0; r < 4; ++r) { const size_t row = row0 + 16 * mt + 4 * q + r; const int col = colw + c16;
                const float ga = bf2f(Gt[row * (2 * DM) + col]), gb = bf2f(Gt[row * (2 * DM) + DM + col]); MRG[row * DM + col] = bf1(ga * acc[0][mt][r] + gb * acc[1][mt][r]); }
    }
}

__device__ __forceinline__ void mod_phase(const Args& a, LAS unsigned char* lds, int vcu, int G, int tid) {
    unsigned char* ws = a.ws; const bf16* AM = (const bf16*)(ws + OFF_AMOD); float* MOD = (float*)(ws + OFF_MOD); const float* WM = INP(I_WMOD); const float* BM_ = INP(I_BMOD);
    const int lane = tid & 63, wave = __builtin_amdgcn_readfirstlane(tid >> 6), q = lane >> 4, c16 = lane & 15;
    constexpr int SW = 144, WT_B = 32 * SW * 4, AT_B = 144 * 32 * 2, BUF_B = WT_B + AT_B, NRING = 5;
    static_assert(NRING * BUF_B <= LDSCTL_OFF && NMODC % SW == 0, "mod ring fits");
    for (int slab = vcu; slab < MODLD / SW; slab += G) { const int lyr = slab / (NMODC / SW), c0 = (slab - lyr * (NMODC / SW)) * SW;
        const float* wsrc = WM + (size_t)lyr * DM * NMODC + c0;
        v4f acc[9], acc2[9];
#pragma unroll
        for (int m = 0; m < 9; ++m) { acc[m] = (v4f){0.f, 0.f, 0.f, 0.f}; acc2[m] = acc[m]; }
#define MOD_STAGE(KB) do { const unsigned bo_ = (unsigned)((KB) % NRING) * BUF_B; \
        _Pragma("unroll") for (int i_ = 0; i_ < 3; ++i_) { int pi_ = wave * 3 + i_; pi_ = pi_ < 18 ? pi_ : pi_ - 18; const int p_ = 64 * pi_ + lane; const int row_ = p_ / 36, c4_ = p_ - row_ * 36; \
            __builtin_amdgcn_global_load_lds((const unsigned*)(wsrc + (size_t)(32 * (KB) + row_) * NMODC + 4 * c4_), (LAS unsigned*)(lds + bo_ + 1024 * pi_), 16, 0, 0); } \
        { const int pi_ = wave; const int row_ = 16 * pi_ + (lane >> 2); __builtin_amdgcn_global_load_lds((const unsigned*)(AM + (size_t)row_ * DM + 32 * (KB) + 8 * (lane & 3)), (LAS unsigned*)(lds + bo_ + WT_B + 1024 * pi_), 16, 0, 0); \
          const int row2_ = 128 + (lane >> 2); __builtin_amdgcn_global_load_lds((const unsigned*)(AM + (size_t)row2_ * DM + 32 * (KB) + 8 * (lane & 3)), (LAS unsigned*)(lds + bo_ + WT_B + 8192), 16, 0, 0); } } while (0)
        asm volatile("s_waitcnt lgkmcnt(0)\n\ts_barrier" ::: "memory");
#pragma unroll
        for (int kb = 0; kb < NRING - 1; ++kb) MOD_STAGE(kb);
        for (int kb = 0; kb < DM / 32; ++kb) {
            if (kb < DM / 32 - (NRING - 1)) asm volatile("s_waitcnt vmcnt(15)" ::: "memory"); else asm volatile("s_waitcnt vmcnt(0)" ::: "memory");
            asm volatile("s_waitcnt lgkmcnt(0)\n\ts_barrier" ::: "memory");
            if (kb + NRING - 1 < DM / 32) MOD_STAGE(kb + NRING - 1);
            const LAS float* WT = (const LAS float*)(lds + (unsigned)(kb % NRING) * BUF_B); const LAS bf16* AT = (const LAS bf16*)(lds + (unsigned)(kb % NRING) * BUF_B + WT_B);
            float w8[8];
#pragma unroll
            for (int j = 0; j < 8; ++j) w8[j] = WT[(8 * q + j) * SW + 16 * wave + c16];
            v4u wb; wb.x = pkbf(w8[0], w8[1]); wb.y = pkbf(w8[2], w8[3]); wb.z = pkbf(w8[4], w8[5]); wb.w = pkbf(w8[6], w8[7]); const v8s bfrag = __builtin_bit_cast(v8s, wb);
#pragma unroll
            for (int m = 0; m < 9; ++m) acc[m] = mfma16(*(const LAS v8s*)(AT + (16 * m + c16) * 32 + 8 * q), bfrag, acc[m]);
            if (wave == 0) {
#pragma unroll
                for (int j = 0; j < 8; ++j) w8[j] = WT[(8 * q + j) * SW + 128 + c16];
                wb.x = pkbf(w8[0], w8[1]); wb.y = pkbf(w8[2], w8[3]); wb.z = pkbf(w8[4], w8[5]); wb.w = pkbf(w8[6], w8[7]); const v8s bfrag2 = __builtin_bit_cast(v8s, wb);
#pragma unroll
                for (int m = 0; m < 9; ++m) acc2[m] = mfma16(*(const LAS v8s*)(AT + (16 * m + c16) * 32 + 8 * q), bfrag2, acc2[m]); }
        }
#undef MOD_STAGE
        { const int gcol = lyr * NMODC + c0 + 16 * wave + c16; const float bias = BM_[gcol];
#pragma unroll
          for (int m = 0; m < 9; ++m)
#pragma unroll
              for (int r = 0; r < 4; ++r) { const int row = 16 * m + 4 * q + r; if (row < NSEQ) MOD[(size_t)row * MODLD + gcol] = acc[m][r] + bias; } }
        if (wave == 0) { const int gcol = lyr * NMODC + c0 + 128 + c16; const float bias = BM_[gcol];
#pragma unroll
          for (int m = 0; m < 9; ++m)
#pragma unroll
              for (int r = 0; r < 4; ++r) { const int row = 16 * m + 4 * q + r; if (row < NSEQ) MOD[(size_t)row * MODLD + gcol] = acc2[m][r] + bias; } }
    }
    asm volatile("s_waitcnt vmcnt(0) lgkmcnt(0)\n\ts_barrier" ::: "memory");
}
#undef MIX_PREFETCH_DMA
#undef MIX_ROW
#undef MIX_BAR
}

#ifndef SITE_MASK
#define SITE_MASK 0xffffffffu
#endif
#define SITE_EN(i) (((SITE_MASK) >> (i)) & 1u)
#ifndef REP_MASK
#define REP_MASK 0u
#endif
#ifndef REP_N
#define REP_N 2
#endif
#define SITE_REPS(i) ((((REP_MASK) >> (i)) & 1u) ? (REP_N) : 1)
constexpr int CW_BAR = 4096;
constexpr int N_PHASES = 2 + 12 * DEPTH + 1;
__global__ void __launch_bounds__(NWAVES * 64, 2) fwd(Args a) {
    extern __shared__ __attribute__((aligned(16))) unsigned char lds_raw[];
    LAS unsigned char* lds0 = (LAS unsigned char*)lds_raw;
    const int tid = threadIdx.x; const int wave0 = __builtin_amdgcn_readfirstlane(tid >> 6);
    const int G = gridDim.x; const int bx = blockIdx.x; const int vcu = (G % 8 == 0) ? (bx % 8) * (G / 8) + bx / 8 : bx;
    unsigned char* ws0 = a.ws;
    for (int u = tid; u < (LDS_BYTES - LDSCTL_OFF) / 4; u += NWAVES * 64) ((LAS unsigned*)(lds0 + LDSCTL_OFF))[u] = 0u;
    __syncthreads();
    if (tid < N_IN) ((LAS unsigned long long*)(lds0 + PTAB_OFF))[tid] = (unsigned long long)a.in[tid];
    __syncthreads();
    XcdBarrier bar; bar.bar = (unsigned*)(ws0 + OFF_CTL) + CW_BAR; bar.x = 0; bar.st = nullptr;
    if (a.use_bar) bar = xcd_barrier_post((unsigned*)(ws0 + OFF_CTL) + CW_BAR, (volatile LAS unsigned*)(lds0 + MISC_OFF) + 8);
    if (a.use_bar) xcd_barrier_census(bar);
    const int lo = a.ph_lo, hi = a.ph_hi; int ph = 0;
#define PH_ON (ph >= lo && ph < hi)
#define SITE_IDS int wave = wave0; asm volatile("" : "+s"(wave)); const int lane = (int)__builtin_amdgcn_mbcnt_hi(~0u, __builtin_amdgcn_mbcnt_lo(~0u, 0u)); int tid_ = wave * 64 + lane; asm volatile("" : "+v"(tid_)); const int gw = vcu * NWAVES + wave, NGW = G * NWAVES; (void)lane; (void)gw; (void)NGW; \
        LAS unsigned char* lds = lds0; asm volatile("" : "+s"(lds));   GAS unsigned char* wsg_ = (GAS unsigned char*)ws0; asm volatile("" : "+s"(wsg_)); unsigned char* ws = (unsigned char*)wsg_; int l = l0; asm volatile("" : "+s"(l));   \
        GAS float* outg_ = (GAS float*)a.out; asm volatile("" : "+s"(outg_)); float* outl = (float*)outg_; Args al; al.ws = ws; al.out = outl;   \
        float* X = (float*)(ws + OFF_X); bf16* H = (bf16*)(ws + OFF_H); const float* MOD = (const float*)(ws + OFF_MOD); const int mb = l * NMODC; const float* ng = INP(I_NG) + (size_t)l * 3 * DM; (void)X; (void)H; (void)MOD; (void)mb; (void)ng;
#define PH_END do { if (PH_ON && ph + 1 < hi) xcd_barrier(bar); ++ph; } while (0)
#define GEMM(EpiT, Ap, Bp, Mv, Nv, Kv, ...) do { pg8::Gemm g_{(const pg8::bf16_t*)(Ap), (const pg8::bf16_t*)(Bp), (Mv), (Nv), (Kv), nullptr, nullptr}; pg8::StaticOrder S_; S_.init((Mv), (Nv), G, bx); \
        pg8::EpiT E_{__VA_ARGS__}; pg8::gemm_phase<pg8::EpiT, pg8::StaticOrder, true, true>(lds + RING_OFF, g_, S_, E_, tid_); } while (0)
#define GEMM_SPLIT(EpiT, Ap, Bp, Nv, Kv, PIECES, PKT, ...) do { pg8::Gemm g_{(const pg8::bf16_t*)(Ap), (const pg8::bf16_t*)(Bp), MT, (Nv), (Kv), nullptr, nullptr}; pg8::SplitOrder S_; S_.init(MP, MS, (Nv), (Kv), G, bx, (PIECES), (PKT)); \
        pg8::EpiT E_{__VA_ARGS__}; pg8::gemm_phase<pg8::EpiT, pg8::SplitOrder, true, true>(lds + RING_OFF, g_, S_, E_, tid_); } while (0)
    int l0 = 0;

    { if (PH_ON && SITE_EN(0)) { constexpr int rep_ = 0; SITE_IDS p0_phase(al, lds, vcu, G, wave, lane); } if (SITE_REPS(0) > 1) { if (PH_ON) xcd_barrier(bar); if (PH_ON && SITE_EN(0)) { constexpr int rep_ = 1; SITE_IDS p0_phase(al, lds, vcu, G, wave, lane); } } }
    PH_END;
    { if (PH_ON && SITE_EN(1)) { constexpr int rep_ = 0; SITE_IDS mix::mod_phase(al, lds, vcu, G, tid_); } if (SITE_REPS(1) > 1) { if (PH_ON) xcd_barrier(bar); if (PH_ON && SITE_EN(1)) { constexpr int rep_ = 1; SITE_IDS mix::mod_phase(al, lds, vcu, G, tid_); } } }
    PH_END;

    for (l0 = 0; l0 < DEPTH; ++l0) {
        { if (PH_ON && SITE_EN(2)) { constexpr int rep_ = 0; SITE_IDS norm_phase(X, ng, MOD, mb + 0 * DM, mb + 1 * DM, H, gw, NGW, lane, (const float*)(ws + OFF_PART), (l > 0 && rep_ == 0) ? 15 : 0, l == 0 ? INP(I_XP) : nullptr, l == 0 ? INP(I_XS) : nullptr); } if (SITE_REPS(2) > 1) { if (PH_ON) xcd_barrier(bar); if (PH_ON && SITE_EN(2)) { constexpr int rep_ = 1; SITE_IDS norm_phase(X, ng, MOD, mb + 0 * DM, mb + 1 * DM, H, gw, NGW, lane, (const float*)(ws + OFF_PART), (l > 0 && rep_ == 0) ? 15 : 0, l == 0 ? INP(I_XP) : nullptr, l == 0 ? INP(I_XS) : nullptr); } } }
        PH_END;
        { if (PH_ON && SITE_EN(3)) { constexpr int rep_ = 0; SITE_IDS GEMM(EpiSwiGLU, H, ws + OFF_WGU + (size_t)(l * 2 + 0) * SZ_WGU, MT, 2 * DFF, DM, (pg8::bf16_t*)(ws + OFF_R1), DFF); } if (SITE_REPS(3) > 1) { if (PH_ON) xcd_barrier(bar); if (PH_ON && SITE_EN(3)) { constexpr int rep_ = 1; SITE_IDS GEMM(EpiSwiGLU, H, ws + OFF_WGU + (size_t)(l * 2 + 0) * SZ_WGU, MT, 2 * DFF, DM, (pg8::bf16_t*)(ws + OFF_R1), DFF); } } }
        PH_END;
        { if (PH_ON && SITE_EN(4)) { constexpr int rep_ = 0; SITE_IDS GEMM_SPLIT(EpiResid, ws + OFF_R1, ws + OFF_WD + (size_t)(l * 2 + 0) * SZ_WD, DM, DFF, 15, 6, X, MOD, mb + 2 * DM, rep_ == 0 ? 0.5f : 0.f, (l == 0 && rep_ == 0) ? INP(I_XP) : (const float*)X); } if (SITE_REPS(4) > 1) { if (PH_ON) xcd_barrier(bar); if (PH_ON && SITE_EN(4)) { constexpr int rep_ = 1; SITE_IDS GEMM_SPLIT(EpiResid, ws + OFF_R1, ws + OFF_WD + (size_t)(l * 2 + 0) * SZ_WD, DM, DFF, 15, 6, X, MOD, mb + 2 * DM, rep_ == 0 ? 0.5f : 0.f, (l == 0 && rep_ == 0) ? INP(I_XP) : (const float*)X); } } }
        PH_END;
        { if (PH_ON && SITE_EN(5)) { constexpr int rep_ = 0; SITE_IDS norm_phase(X, ng + DM, MOD, mb + 3 * DM, mb + 4 * DM, H, gw, NGW, lane, (const float*)(ws + OFF_PART), rep_ == 0 ? 15 : 0, nullptr, (l == 0 && rep_ == 0) ? INP(I_XS) : nullptr); } if (SITE_REPS(5) > 1) { if (PH_ON) xcd_barrier(bar); if (PH_ON && SITE_EN(5)) { constexpr int rep_ = 1; SITE_IDS norm_phase(X, ng + DM, MOD, mb + 3 * DM, mb + 4 * DM, H, gw, NGW, lane, (const float*)(ws + OFF_PART), rep_ == 0 ? 15 : 0, nullptr, (l == 0 && rep_ == 0) ? INP(I_XS) : nullptr); } } }
        PH_END;
        { if (PH_ON && SITE_EN(6)) { constexpr int rep_ = 0; SITE_IDS GEMM(EpiInProj, H, ws + OFF_WIN + (size_t)l * SZ_WIN, MT, NIN, DM, (float*)(ws + OFF_PA), (pg8::bf16_t*)(ws + OFF_PB), (pg8::bf16_t*)(ws + OFF_G)); } if (SITE_REPS(6) > 1) { if (PH_ON) xcd_barrier(bar); if (PH_ON && SITE_EN(6)) { constexpr int rep_ = 1; SITE_IDS GEMM(EpiInProj, H, ws + OFF_WIN + (size_t)l * SZ_WIN, MT, NIN, DM, (float*)(ws + OFF_PA), (pg8::bf16_t*)(ws + OFF_PB), (pg8::bf16_t*)(ws + OFF_G)); } } }
        PH_END;
        { if (PH_ON && SITE_EN(9)) { constexpr int rep_ = 0; { SITE_IDS mix::mixa_phase<true>(al, l, lds, vcu, G, tid_); } { SITE_IDS e1_phase(al, l, gw, NGW, lane, rep_ == 0 ? 1 : -1); if (rep_ == 1) e1_phase(al, l, gw, NGW, lane, 1); } } if (SITE_REPS(9) > 1) { if (PH_ON) xcd_barrier(bar); if (PH_ON && SITE_EN(9)) { constexpr int rep_ = 1; { SITE_IDS mix::mixa_phase<true>(al, l, lds, vcu, G, tid_); } { SITE_IDS e1_phase(al, l, gw, NGW, lane, rep_ == 0 ? 1 : -1); if (rep_ == 1) e1_phase(al, l, gw, NGW, lane, 1); } } } }
        PH_END;
        { if (PH_ON && SITE_EN(11)) { constexpr int rep_ = 0; { SITE_IDS mix::mixb_phase(al, l, lds, vcu, G, tid_); } { SITE_IDS attn_phase(al, l, lds, gw, NGW, wave, lane); } } if (SITE_REPS(11) > 1) { if (PH_ON) xcd_barrier(bar); if (PH_ON && SITE_EN(11)) { constexpr int rep_ = 1; { SITE_IDS mix::mixb_phase(al, l, lds, vcu, G, tid_); } { SITE_IDS attn_phase(al, l, lds, gw, NGW, wave, lane); } } } }
        PH_END;
        { if (PH_ON && SITE_EN(12)) { constexpr int rep_ = 0; SITE_IDS { pg8::Gemm g_{(const pg8::bf16_t*)(ws + OFF_YA), (const pg8::bf16_t*)(ws + OFF_WA + (size_t)l * SZ_WAB), MT, DM, AW, (const pg8::bf16_t*)(ws + OFF_YB), (const pg8::bf16_t*)(ws + OFF_WB + (size_t)l * SZ_WAB)}; pg8::PairOrder S_; S_.init(MP, DM, G, bx); pg8::EpiBranch E_{(const pg8::bf16_t*)(ws + OFF_G), (pg8::bf16_t*)(ws + OFF_MRG)}; pg8::gemm_phase<pg8::EpiBranch, pg8::PairOrder, true, true>(lds + RING_OFF, g_, S_, E_, tid_); } mix::mini_branch(al, l, vcu, G, tid_); } if (SITE_REPS(12) > 1) { if (PH_ON) xcd_barrier(bar); if (PH_ON && SITE_EN(12)) { constexpr int rep_ = 1; SITE_IDS { pg8::Gemm g_{(const pg8::bf16_t*)(ws + OFF_YA), (const pg8::bf16_t*)(ws + OFF_WA + (size_t)l * SZ_WAB), MT, DM, AW, (const pg8::bf16_t*)(ws + OFF_YB), (const pg8::bf16_t*)(ws + OFF_WB + (size_t)l * SZ_WAB)}; pg8::PairOrder S_; S_.init(MP, DM, G, bx); pg8::EpiBranch E_{(const pg8::bf16_t*)(ws + OFF_G), (pg8::bf16_t*)(ws + OFF_MRG)}; pg8::gemm_phase<pg8::EpiBranch, pg8::PairOrder, true, true>(lds + RING_OFF, g_, S_, E_, tid_); } mix::mini_branch(al, l, vcu, G, tid_); } } }
        PH_END;
        { if (PH_ON && SITE_EN(14)) { constexpr int rep_ = 0; SITE_IDS GEMM_SPLIT(EpiResid, ws + OFF_MRG, ws + OFF_WOUT + (size_t)l * SZ_WOUT, DM, DM, 8, 4, X, MOD, mb + 5 * DM, rep_ == 0 ? 1.0f : 0.f, (const float*)X); } if (SITE_REPS(14) > 1) { if (PH_ON) xcd_barrier(bar); if (PH_ON && SITE_EN(14)) { constexpr int rep_ = 1; SITE_IDS GEMM_SPLIT(EpiResid, ws + OFF_MRG, ws + OFF_WOUT + (size_t)l * SZ_WOUT, DM, DM, 8, 4, X, MOD, mb + 5 * DM, rep_ == 0 ? 1.0f : 0.f, (const float*)X); } } }
        PH_END;
        { if (PH_ON && SITE_EN(15)) { constexpr int rep_ = 0; SITE_IDS norm_phase(X, ng + 2 * DM, MOD, mb + 6 * DM, mb + 7 * DM, H, gw, NGW, lane, (const float*)(ws + OFF_PART), rep_ == 0 ? 8 : 0, nullptr, nullptr); } if (SITE_REPS(15) > 1) { if (PH_ON) xcd_barrier(bar); if (PH_ON && SITE_EN(15)) { constexpr int rep_ = 1; SITE_IDS norm_phase(X, ng + 2 * DM, MOD, mb + 6 * DM, mb + 7 * DM, H, gw, NGW, lane, (const float*)(ws + OFF_PART), rep_ == 0 ? 8 : 0, nullptr, nullptr); } } }
        PH_END;
        { if (PH_ON && SITE_EN(16)) { constexpr int rep_ = 0; SITE_IDS GEMM(EpiSwiGLU, H, ws + OFF_WGU + (size_t)(l * 2 + 1) * SZ_WGU, MT, 2 * DFF, DM, (pg8::bf16_t*)(ws + OFF_R1), DFF); } if (SITE_REPS(16) > 1) { if (PH_ON) xcd_barrier(bar); if (PH_ON && SITE_EN(16)) { constexpr int rep_ = 1; SITE_IDS GEMM(EpiSwiGLU, H, ws + OFF_WGU + (size_t)(l * 2 + 1) * SZ_WGU, MT, 2 * DFF, DM, (pg8::bf16_t*)(ws + OFF_R1), DFF); } } }
        PH_END;
        { if (PH_ON && SITE_EN(17)) { constexpr int rep_ = 0; SITE_IDS GEMM_SPLIT(EpiResid, ws + OFF_R1, ws + OFF_WD + (size_t)(l * 2 + 1) * SZ_WD, DM, DFF, 15, 6, X, MOD, mb + 8 * DM, rep_ == 0 ? 0.5f : 0.f, (const float*)X); } if (SITE_REPS(17) > 1) { if (PH_ON) xcd_barrier(bar); if (PH_ON && SITE_EN(17)) { constexpr int rep_ = 1; SITE_IDS GEMM_SPLIT(EpiResid, ws + OFF_R1, ws + OFF_WD + (size_t)(l * 2 + 1) * SZ_WD, DM, DFF, 15, 6, X, MOD, mb + 8 * DM, rep_ == 0 ? 0.5f : 0.f, (const float*)X); } } }
        PH_END;
    }
#ifdef DUMP_OFF
    if (PH_ON) { SITE_IDS const size_t n = (size_t)DUMP_ELEMS; for (size_t i = (size_t)gw * 64 + lane; i < n; i += (size_t)NGW * 64) a.out[i] = DUMP_BF16 ? bf2f(((const bf16*)(ws + DUMP_OFF))[i]) : ((const float*)(ws + DUMP_OFF))[i]; }
#else
    if (PH_ON && SITE_EN(18)) { SITE_IDS final_norm_phase(X, INP(I_FN), outl + OUT_Y, gw, NGW, lane, (const float*)(ws + OFF_PART), 15); }
#endif
    PH_END;
#undef PH_ON
#undef PH_END
#undef GEMM
#undef GEMM_SPLIT
}

#ifndef MK_PER_PHASE
#define MK_PER_PHASE 0
#endif
extern "C" void kernel_launch(void* const* d_in, const int* in_sizes, int n_in, void* d_out, int out_size, void* d_ws, size_t ws_size, hipStream_t stream) {
    static int grid = 0;
    if (grid == 0) {
        if (n_in != N_IN || out_size != (int)OUT_END || ws_size < WS_END) { fprintf(stderr, "kernel_launch: shape mismatch: n_in %d out %d ws %zu (need %zu)\n", n_in, out_size, ws_size, (size_t)WS_END); grid = -1; return; }
        int dev = 0, cus = 0, per_cu = 0;
        if (hipGetDevice(&dev) != hipSuccess || hipDeviceGetAttribute(&cus, hipDeviceAttributeMultiprocessorCount, dev) != hipSuccess) { grid = -1; return; }
        if (hipFuncSetAttribute((const void*)fwd, hipFuncAttributeMaxDynamicSharedMemorySize, LDS_BYTES) != hipSuccess) { fprintf(stderr, "kernel_launch: hipFuncSetAttribute failed\n"); grid = -1; return; }
        if (hipOccupancyMaxActiveBlocksPerMultiprocessor(&per_cu, (const void*)fwd, NWAVES * 64, LDS_BYTES) != hipSuccess || per_cu < 1) fprintf(stderr, "kernel_launch: occupancy query reports %d\n", per_cu);
        (void)hipGetLastError();
        grid = cus;
    }
    if (grid < 0) return;
    (void)hipMemsetAsync((char*)d_ws + OFF_CTL, 0, (size_t)(CW_BAR + XCD_BAR_WORDS) * 4, stream);
    Args a{};
    for (int i = 0; i < N_IN; ++i) a.in[i] = (const float*)d_in[i];
    a.out = (float*)d_out; a.ws = (unsigned char*)d_ws; a.pad = 0;
#if MK_PER_PHASE
#ifndef LAST_PHASE
#define LAST_PHASE (N_PHASES - 2)
#endif
    for (int p = 0; p < N_PHASES; ++p) { if (p > LAST_PHASE && p != N_PHASES - 1) continue; a.ph_lo = p; a.ph_hi = p + 1; a.use_bar = 0;
        hipLaunchKernelGGL(fwd, dim3(grid), dim3(NWAVES * 64), LDS_BYTES, stream, a); }
#else
    a.ph_lo = 0; a.ph_hi = N_PHASES; a.use_bar = 1;
    hipLaunchKernelGGL(fwd, dim3(grid), dim3(NWAVES * 64), LDS_BYTES, stream, a);
#endif
    const hipError_t le = hipPeekAtLastError();
    if (le != hipSuccess) fprintf(stderr, "kernel_launch: launch failed: %s\n", hipGetErrorName(le));
}
```
